# Optimizing an MI355X kernel written in HIP

```python
import math
import jax
import jax.numpy as jnp
from jax import lax
import numpy as np

D_MODEL = 1024
BATCH = 8
SEQ = 2048
DEPTH = 1

CHUNK = 64
N_META = 16
D_MIX = D_MODEL
A_WIDTH = D_MIX // 2
A_HEAD_DIM = 64
A_HEADS = A_WIDTH // (2 * A_HEAD_DIM)
B_WIDTH = D_MIX - A_WIDTH
B_KEY_DIM = 128
B_VAL_DIM = 128
B_HEADS = B_WIDTH // B_VAL_DIM
ROPE_THETA = 10000.0
Q_BLOCK = 128
A_QK = A_HEADS * 2 * A_HEAD_DIM
A_V = A_HEADS * 2 * A_HEAD_DIM
B_QF = B_HEADS * B_KEY_DIM
B_IG = B_HEADS * B_VAL_DIM
IN_SPLITS = (A_QK, A_QK, A_V, B_QF, B_QF, B_IG, B_IG)
D_IN = A_QK * 2 + A_V + B_QF * 2 + B_IG * 2
N_EXPERTS = 32
TOP_K = 4
D_EXPERT = D_MODEL
SWIGLU_ALPHA = 1.702
SWIGLU_LIMIT = 7.0
EXPERT_BLOCK = 256
DEEPNORM_ALPHA = (2 * DEPTH) ** 0.25
DEEPNORM_BETA = (8 * DEPTH) ** -0.25
LN_EPS = 1e-5
RMS_EPS = 1e-5

kernel_name = 'hybrid_diffattn_hgrn2_moe_block'


def layer_norm(x, g, b):
    xf = x.astype(jnp.float32)
    mu = jnp.mean(xf, axis=-1, keepdims=True)
    var = jnp.mean(jnp.square(xf - mu), axis=-1, keepdims=True)
    return ((xf - mu) * lax.rsqrt(var + LN_EPS) * g.astype(jnp.float32) + b.astype(jnp.float32)).astype(x.dtype)


def rms_norm(x, g):
    xf = x.astype(jnp.float32)
    ms = jnp.mean(jnp.square(xf), axis=-1, keepdims=True)
    return (xf * lax.rsqrt(ms + RMS_EPS) * g.astype(jnp.float32)).astype(x.dtype)


def chunk_ids(L):
    p = np.arange(L)
    return np.where(p < N_META, 0, 1 + (p - N_META) // CHUNK)


def chunk_end(p, L):
    if p < N_META:
        end = N_META
    else:
        end = N_META + CHUNK * ((p - N_META) // CHUNK + 1)
    return min(end, L)


def rope_tables(L, dim):
    pos = jnp.arange(L, dtype=jnp.float32)
    inv = 1.0 / (ROPE_THETA ** (jnp.arange(0, dim, 2, dtype=jnp.float32) / dim))
    ang = pos[:, None] * inv[None, :]
    ang = jnp.concatenate([ang, ang], axis=-1)
    return jnp.cos(ang), jnp.sin(ang)


def apply_rope(x, cos, sin):
    xf = x.astype(jnp.float32)
    half = xf.shape[-1] // 2
    rot = jnp.concatenate([-xf[..., half:], xf[..., :half]], axis=-1)
    return (xf * cos + rot * sin).astype(x.dtype)


def diff_attention(q, k, v, lam, subln_g, lam_init, cos, sin):
    B, L, _ = q.shape
    q = q.reshape(B, L, A_HEADS, 2, A_HEAD_DIM).transpose(0, 2, 3, 1, 4)
    k = k.reshape(B, L, A_HEADS, 2, A_HEAD_DIM).transpose(0, 2, 3, 1, 4)
    v = v.reshape(B, L, A_HEADS, 2 * A_HEAD_DIM).transpose(0, 2, 1, 3)
    q = apply_rope(q, cos, sin) * (A_HEAD_DIM ** -0.5)
    k = apply_rope(k, cos, sin)
    cid = chunk_ids(L)
    outs = []
    for qs in range(0, L, Q_BLOCK):
        qe = min(qs + Q_BLOCK, L)
        ke = chunk_end(qe - 1, L)
        s = jnp.einsum('bhmqd,bhmkd->bhmqk', q[:, :, :, qs:qe], k[:, :, :, :ke]).astype(jnp.float32)
        mask = jnp.asarray(cid[qs:qe, None] >= cid[None, :ke])
        p = jax.nn.softmax(jnp.where(mask, s, -jnp.inf), axis=-1)
        a = p[:, :, 0] - lam * p[:, :, 1]
        outs.append(jnp.einsum('bhqk,bhkd->bhqd', a.astype(v.dtype), v[:, :, :ke]))
    o = jnp.concatenate(outs, axis=2)
    o = rms_norm(o, subln_g) * (1.0 - lam_init)
    return o.transpose(0, 2, 1, 3).reshape(B, L, A_V)


def hgrn2(q, f, i, g, lb, norm_g):
    B, L, _ = q.shape

    def heads(t, d):
        return t.reshape(B, L, B_HEADS, d).transpose(0, 2, 1, 3).astype(jnp.float32)

    qh = jax.nn.silu(heads(q, B_KEY_DIM)) * (B_KEY_DIM ** -0.5)
    z = heads(f, B_KEY_DIM)
    lbh = lb.astype(jnp.float32).reshape(B_HEADS, 1, B_KEY_DIM)
    log_f = jnp.log(lbh + (1.0 - lbh) * jax.nn.sigmoid(z))
    kh = (1.0 - lbh) * jax.nn.sigmoid(-z)
    vh = heads(i, B_VAL_DIM)
    pad = (-L) % CHUNK
    padw = ((0, 0), (0, 0), (pad, 0), (0, 0))
    qh, kh, vh, log_f = (jnp.pad(t, padw) for t in (qh, kh, vh, log_f))
    n = (L + pad) // CHUNK

    def to_chunks(t):
        return t.reshape(B, B_HEADS, n, CHUNK, t.shape[-1]).transpose(2, 0, 1, 3, 4)

    causal = jnp.tril(jnp.ones((CHUNK, CHUNK), dtype=bool))

    def step(S, inp):
        qc, kc, vc, lfc = inp
        b = jnp.cumsum(lfc, axis=2)
        decay = jnp.exp(jnp.where(causal[:, :, None], b[:, :, :, None, :] - b[:, :, None, :, :], -jnp.inf))
        scores = jnp.einsum('bhtk,bhsk,bhtsk->bhts', qc, kc, decay)
        o = jnp.einsum('bhts,bhsv->bhtv', scores, vc) + jnp.einsum('bhtk,bhkv->bhtv', qc * jnp.exp(b), S)
        b_last = b[:, :, -1:, :]
        S = S * jnp.exp(b_last[:, :, 0, :, None]) + jnp.einsum('bhsk,bhsv->bhkv', kc * jnp.exp(b_last - b), vc)
        return S, o

    S0 = jnp.zeros((B, B_HEADS, B_KEY_DIM, B_VAL_DIM), jnp.float32)
    _, o = lax.scan(step, S0, (to_chunks(qh), to_chunks(kh), to_chunks(vh), to_chunks(log_f)))
    o = o.transpose(1, 2, 0, 3, 4).reshape(B, B_HEADS, n * CHUNK, B_VAL_DIM)[:, :, pad:]
    o = rms_norm(o, norm_g) * jax.nn.silu(heads(g, B_VAL_DIM))
    return o.transpose(0, 2, 1, 3).reshape(B, L, B_WIDTH).astype(q.dtype)


def moe(h, w_router, b_router, w_gu, b_gu, w_dn, b_dn):
    T, D = h.shape
    logits = (h @ w_router).astype(jnp.float32) + b_router.astype(jnp.float32)
    top_val, top_idx = lax.top_k(logits, TOP_K)
    gates = jax.nn.softmax(top_val, axis=-1)
    A = T * TOP_K
    e_flat = top_idx.reshape(A).astype(jnp.int32)
    order = jnp.argsort(e_flat)
    e_sorted = e_flat[order]
    counts = jnp.bincount(e_flat, length=N_EXPERTS)
    padded = ((counts + EXPERT_BLOCK - 1) // EXPERT_BLOCK) * EXPERT_BLOCK
    start_sorted = jnp.cumsum(counts) - counts
    cum_pad = jnp.cumsum(padded)
    start_pad = cum_pad - padded
    dest_sorted = (start_pad[e_sorted] + (jnp.arange(A) - start_sorted[e_sorted])).astype(jnp.int32)
    n_blocks = -(-A // EXPERT_BLOCK) + N_EXPERTS
    P = n_blocks * EXPERT_BLOCK
    row_token = jnp.full((P,), T, dtype=jnp.int32).at[dest_sorted].set((order // TOP_K).astype(jnp.int32))
    h_pad = jnp.concatenate([h, jnp.zeros((1, D), h.dtype)], axis=0)
    x_rows = h_pad[row_token].reshape(n_blocks, EXPERT_BLOCK, D)
    block_expert = jnp.clip(jnp.searchsorted(cum_pad, jnp.arange(n_blocks) * EXPERT_BLOCK, side='right'), 0, N_EXPERTS - 1)

    def expert_block(args):
        xb, e = args
        gu = xb @ w_gu[e] + b_gu[e]
        gate = jnp.minimum(gu[:, 0::2], SWIGLU_LIMIT)
        up = jnp.clip(gu[:, 1::2], -SWIGLU_LIMIT, SWIGLU_LIMIT)
        act = (up + 1.0) * gate * jax.nn.sigmoid(gate * SWIGLU_ALPHA)
        return act @ w_dn[e] + b_dn[e]

    y = lax.map(expert_block, (x_rows, block_expert)).reshape(P, D)
    dest = jnp.zeros((A,), jnp.int32).at[order].set(dest_sorted)
    y_assign = y[dest].reshape(T, TOP_K, D)
    return jnp.einsum('tkd,tk->td', y_assign, gates.astype(y.dtype))


def setup_inputs(seed: int = 0) -> dict:
    key = jax.random.key(seed)
    ks = jax.random.split(key, 24)
    f32 = jnp.float32
    nrm = lambda k, s: jax.random.normal(k, s, f32)
    return {
        'x': nrm(ks[0], (BATCH, SEQ, D_MODEL)),
        'meta_tokens': nrm(ks[1], (N_META, D_MODEL)),
        'ln_emb_g': 1.0 + 0.02 * nrm(ks[2], (D_MODEL,)),
        'ln_emb_b': 0.02 * nrm(ks[3], (D_MODEL,)),
        'w_in': nrm(ks[4], (DEPTH, D_MODEL, D_IN)) * D_MODEL ** -0.5,
        'lambda_q1': 0.1 * nrm(ks[5], (DEPTH, A_HEAD_DIM)),
        'lambda_k1': 0.1 * nrm(ks[6], (DEPTH, A_HEAD_DIM)),
        'lambda_q2': 0.1 * nrm(ks[7], (DEPTH, A_HEAD_DIM)),
        'lambda_k2': 0.1 * nrm(ks[8], (DEPTH, A_HEAD_DIM)),
        'subln_g': 1.0 + 0.02 * nrm(ks[9], (DEPTH, 2 * A_HEAD_DIM)),
        'hgrn_lb_table': 0.5 * nrm(ks[10], (DEPTH + 1, B_QF)),
        'hgrn_norm_g': 1.0 + 0.02 * nrm(ks[11], (DEPTH, B_VAL_DIM)),
        'w_out': nrm(ks[12], (DEPTH, D_MIX, D_MODEL)) * (D_MIX ** -0.5) * DEEPNORM_BETA,
        'ln1_g': 1.0 + 0.02 * nrm(ks[13], (DEPTH, D_MODEL)),
        'ln1_b': 0.02 * nrm(ks[14], (DEPTH, D_MODEL)),
        'w_router': nrm(ks[15], (DEPTH, D_MODEL, N_EXPERTS)) * D_MODEL ** -0.5,
        'b_router': 0.01 * nrm(ks[16], (DEPTH, N_EXPERTS)),
        'w_gate_up': nrm(ks[17], (DEPTH, N_EXPERTS, D_MODEL, 2 * D_EXPERT)) * D_MODEL ** -0.5,
        'b_gate_up': 0.01 * nrm(ks[18], (DEPTH, N_EXPERTS, 2 * D_EXPERT)),
        'w_down': nrm(ks[19], (DEPTH, N_EXPERTS, D_EXPERT, D_MODEL)) * (D_EXPERT ** -0.5) * DEEPNORM_BETA,
        'b_down': 0.01 * nrm(ks[20], (DEPTH, N_EXPERTS, D_MODEL)),
        'ln2_g': 1.0 + 0.02 * nrm(ks[21], (DEPTH, D_MODEL)),
        'ln2_b': 0.02 * nrm(ks[22], (DEPTH, D_MODEL)),
    }


def reference(x, meta_tokens, ln_emb_g, ln_emb_b, w_in, lambda_q1, lambda_k1, lambda_q2, lambda_k2,
              subln_g, hgrn_lb_table, hgrn_norm_g, w_out, ln1_g, ln1_b, w_router, b_router,
              w_gate_up, b_gate_up, w_down, b_down, ln2_g, ln2_b):
    B = x.shape[0]
    meta = jnp.broadcast_to(meta_tokens[None].astype(x.dtype), (B, N_META, D_MODEL))
    h = layer_norm(jnp.concatenate([meta, x], axis=1), ln_emb_g, ln_emb_b)
    L = h.shape[1]
    cos, sin = rope_tables(L, A_HEAD_DIM)
    lb_all = jnp.cumsum(jax.nn.softmax(hgrn_lb_table.astype(jnp.float32), axis=0), axis=0)
    split_at = [int(c) for c in np.cumsum(IN_SPLITS)[:-1]]
    for l in range(DEPTH):
        lam_init = 0.8 - 0.6 * math.exp(-0.3 * l)
        proj = jnp.einsum('bld,de->ble', h, w_in[l])
        qa, ka, va, qb, fb, ib, gb = jnp.split(proj, split_at, axis=-1)
        lam = (jnp.exp(jnp.sum(lambda_q1[l].astype(jnp.float32) * lambda_k1[l].astype(jnp.float32)))
               - jnp.exp(jnp.sum(lambda_q2[l].astype(jnp.float32) * lambda_k2[l].astype(jnp.float32)))
               + lam_init)
        ya = diff_attention(qa, ka, va, lam, subln_g[l], lam_init, cos, sin)
        yb = hgrn2(qb, fb, ib, gb, lb_all[l], hgrn_norm_g[l])
        mix = jnp.einsum('ble,ed->bld', jnp.concatenate([ya, yb], axis=-1), w_out[l])
        h = layer_norm(DEEPNORM_ALPHA * h + mix, ln1_g[l], ln1_b[l])
        ffn = moe(h.reshape(-1, D_MODEL), w_router[l], b_router[l], w_gate_up[l], b_gate_up[l],
                  w_down[l], b_down[l]).reshape(h.shape)
        h = layer_norm(DEEPNORM_ALPHA * h + ffn, ln2_g[l], ln2_b[l])
    return h[:, N_META:]
```

```cpp
#include <hip/hip_runtime.h>
#include <cstdint>
#include <cstdio>

namespace {
constexpr int D = 1024, NB = 8, SEQ = 2048, NMETA = 16, L = SEQ + NMETA, T = NB * L;
constexpr int DIN = 3584, NE = 32, TOPK = 4, NA = T * TOPK;
constexpr int OFF_QA = 0, OFF_KA = 512, OFF_VA = 1024, OFF_QB = 1536, OFF_FB = 2048, OFF_IB = 2560, OFF_GB = 3072;
constexpr float LN_EPS = 1e-5f, RMS_EPS = 1e-5f;
constexpr float ALPHA = 1.189207115002721f;
constexpr float LAM_INIT = 0.2f;

__device__ __forceinline__ float sigmoidf_(float x) { return 1.0f / (1.0f + expf(-x)); }
__device__ __forceinline__ float siluf_(float x) { return x * sigmoidf_(x); }

__device__ __forceinline__ float block_sum(float v, float* red) {
    for (int o = 32; o > 0; o >>= 1) v += __shfl_xor(v, o);
    __syncthreads();
    if ((threadIdx.x & 63) == 0) red[threadIdx.x >> 6] = v;
    __syncthreads();
    float r = 0.f; const int nw = blockDim.x >> 6;
    for (int i = 0; i < nw; ++i) r += red[i];
    return r;
}
__device__ __forceinline__ float block_max(float v, float* red) {
    for (int o = 32; o > 0; o >>= 1) v = fmaxf(v, __shfl_xor(v, o));
    __syncthreads();
    if ((threadIdx.x & 63) == 0) red[threadIdx.x >> 6] = v;
    __syncthreads();
    float r = -INFINITY; const int nw = blockDim.x >> 6;
    for (int i = 0; i < nw; ++i) r = fmaxf(r, red[i]);
    return r;
}

__global__ void __launch_bounds__(256) ln_rows_k(const float* x, const float* meta, const float* src, const float* g, const float* b, float* out, int mode) {
    __shared__ float red[8];
    const int row = blockIdx.x;
    const float* in;
    if (mode == 0) { const int bb = row / L, l = row % L; in = (l < NMETA) ? meta + (size_t)l * D : x + ((size_t)bb * SEQ + (l - NMETA)) * D; }
    else in = src + (size_t)row * D;
    const float4 v = *(const float4*)(in + threadIdx.x * 4);
    const float mu = block_sum(v.x + v.y + v.z + v.w, red) * (1.0f / D);
    const float d0 = v.x - mu, d1 = v.y - mu, d2 = v.z - mu, d3 = v.w - mu;
    const float var = block_sum(d0 * d0 + d1 * d1 + d2 * d2 + d3 * d3, red) * (1.0f / D);
    const float rs = 1.0f / sqrtf(var + LN_EPS);
    const float4 gv = *(const float4*)(g + threadIdx.x * 4), bv = *(const float4*)(b + threadIdx.x * 4);
    float4 o; o.x = d0 * rs * gv.x + bv.x; o.y = d1 * rs * gv.y + bv.y; o.z = d2 * rs * gv.z + bv.z; o.w = d3 * rs * gv.w + bv.w;
    *(float4*)(out + (size_t)row * D + threadIdx.x * 4) = o;
}

template <class F> __global__ void __launch_bounds__(256) sgemm_k(F f) {
    __shared__ float As[16][68];
    __shared__ float Bs[16][64];
    const int g = blockIdx.z, M = f.rows(g), r0 = blockIdx.y * 64;
    if (r0 >= M) return;
    const int c0 = blockIdx.x * 64, tid = threadIdx.x;
    const float* Bm = f.B(g); const int ldb = f.ldb(), K = f.K();
    const int ar = tid >> 2, ak = (tid & 3) * 4;
    const float* arow = (r0 + ar < M) ? f.A(g, r0 + ar) : nullptr;
    const int bk = tid >> 4, bc = (tid & 15) * 4, ty = tid >> 4, tx = tid & 15;
    float acc[4][4];
#pragma unroll
    for (int i = 0; i < 4; ++i)
#pragma unroll
        for (int j = 0; j < 4; ++j) acc[i][j] = 0.f;
    for (int k0 = 0; k0 < K; k0 += 16) {
        float4 av = make_float4(0.f, 0.f, 0.f, 0.f);
        if (arow) av = *(const float4*)(arow + k0 + ak);
        const float4 bv = *(const float4*)(Bm + (size_t)(k0 + bk) * ldb + c0 + bc);
        As[ak + 0][ar] = av.x; As[ak + 1][ar] = av.y; As[ak + 2][ar] = av.z; As[ak + 3][ar] = av.w;
        *(float4*)&Bs[bk][bc] = bv;
        __syncthreads();
#pragma unroll
        for (int k = 0; k < 16; ++k) {
            const float4 a = *(const float4*)&As[k][ty * 4]; const float4 b = *(const float4*)&Bs[k][tx * 4];
            const float aa[4] = {a.x, a.y, a.z, a.w}, bb[4] = {b.x, b.y, b.z, b.w};
#pragma unroll
            for (int i = 0; i < 4; ++i)
#pragma unroll
                for (int j = 0; j < 4; ++j) acc[i][j] = fmaf(aa[i], bb[j], acc[i][j]);
        }
        __syncthreads();
    }
#pragma unroll
    for (int i = 0; i < 4; ++i) { const int r = r0 + ty * 4 + i; if (r < M) f.epi(g, r, c0 + tx * 4, acc[i][0], acc[i][1], acc[i][2], acc[i][3]); }
}

struct GemmIn {
    const float* h0; const float* w; float* out;
    __device__ int rows(int) const { return T; }
    __device__ const float* B(int) const { return w; }
    __device__ int ldb() const { return DIN; }
    __device__ int K() const { return D; }
    __device__ const float* A(int, int r) const { return h0 + (size_t)r * D; }
    __device__ void epi(int, int r, int c, float a, float b, float c2, float d) const { *(float4*)(out + (size_t)r * DIN + c) = make_float4(a, b, c2, d); }
};
struct GemmOut {
    const float* y; const float* w; const float* h0; float* out;
    __device__ int rows(int) const { return T; }
    __device__ const float* B(int) const { return w; }
    __device__ int ldb() const { return D; }
    __device__ int K() const { return D; }
    __device__ const float* A(int, int r) const { return y + (size_t)r * D; }
    __device__ void epi(int, int r, int c, float a, float b, float c2, float d) const {
        const float4 h = *(const float4*)(h0 + (size_t)r * D + c);
        *(float4*)(out + (size_t)r * D + c) = make_float4(ALPHA * h.x + a, ALPHA * h.y + b, ALPHA * h.z + c2, ALPHA * h.w + d);
    }
};
struct GemmGU {
    const float* h1; const float* w; const float* bias; const int* cnt; const int* list; float* act;
    __device__ int rows(int e) const { return cnt[e]; }
    __device__ const float* B(int e) const { return w + (size_t)e * D * 2 * D; }
    __device__ int ldb() const { return 2 * D; }
    __device__ int K() const { return D; }
    __device__ int off(int e) const { int o = 0; for (int i = 0; i < e; ++i) o += cnt[i]; return o; }
    __device__ const float* A(int e, int r) const { return h1 + (size_t)(list[(size_t)e * T + r] >> 2) * D; }
    __device__ void epi(int e, int r, int c, float g0, float u0, float g1, float u1) const {
        const float* bb = bias + (size_t)e * 2 * D + c;
        g0 += bb[0]; u0 += bb[1]; g1 += bb[2]; u1 += bb[3];
        g0 = fminf(g0, 7.0f); g1 = fminf(g1, 7.0f);
        u0 = fminf(fmaxf(u0, -7.0f), 7.0f); u1 = fminf(fmaxf(u1, -7.0f), 7.0f);
        const float a0 = (u0 + 1.0f) * g0 * sigmoidf_(g0 * 1.702f), a1 = (u1 + 1.0f) * g1 * sigmoidf_(g1 * 1.702f);
        float* o = act + (size_t)(off(e) + r) * D + (c >> 1);
        o[0] = a0; o[1] = a1;
    }
};
struct GemmDN {
    const float* act; const float* w; const float* bias; const int* cnt; float* y;
    __device__ int rows(int e) const { return cnt[e]; }
    __device__ const float* B(int e) const { return w + (size_t)e * D * D; }
    __device__ int ldb() const { return D; }
    __device__ int K() const { return D; }
    __device__ int off(int e) const { int o = 0; for (int i = 0; i < e; ++i) o += cnt[i]; return o; }
    __device__ const float* A(int e, int r) const { return act + (size_t)(off(e) + r) * D; }
    __device__ void epi(int e, int r, int c, float a, float b, float c2, float d) const {
        const float* bb = bias + (size_t)e * D + c;
        *(float4*)(y + (size_t)(off(e) + r) * D + c) = make_float4(a + bb[0], b + bb[1], c2 + bb[2], d + bb[3]);
    }
};

__global__ void __launch_bounds__(256) rope_k(const float* proj, float* qr, float* kr) {
    const int row = blockIdx.x, pos = row % L;
    for (int idx = threadIdx.x; idx < 2 * 8 * 32; idx += 256) {
        const int which = idx >> 8, hm = (idx >> 5) & 7, j = idx & 31;
        const float inv = 1.0f / powf(10000.0f, (float)(2 * j) / 64.0f);
        const float ang = (float)pos * inv;
        const float c = cosf(ang), s = sinf(ang);
        const float* src = proj + (size_t)row * DIN + (which ? OFF_KA : OFF_QA) + hm * 64;
        const float x0 = src[j], x1 = src[j + 32];
        float o0 = x0 * c - x1 * s, o1 = x1 * c + x0 * s;
        if (!which) { o0 *= 0.125f; o1 *= 0.125f; }
        float* dst = (which ? kr : qr) + (size_t)row * 512 + hm * 64;
        dst[j] = o0; dst[j + 32] = o1;
    }
}

__global__ void __launch_bounds__(256) attn_k(const float* qr, const float* kr, const float* proj, const float* lq1, const float* lk1, const float* lq2, const float* lk2,
                                              const float* subln_g, float* y) {
    __shared__ float s1[L], s2[L], qs[128], red[8], part[128];
    const int q = blockIdx.x, h = blockIdx.y, b = blockIdx.z, tid = threadIdx.x;
    const int ke = (q < NMETA) ? NMETA : min(L, NMETA + 64 * ((q - NMETA) / 64 + 1));
    if (tid < 128) qs[tid] = qr[((size_t)b * L + q) * 512 + h * 128 + tid];
    float lam;
    { float a = 0.f, c = 0.f; for (int i = 0; i < 64; ++i) { a += lq1[i] * lk1[i]; c += lq2[i] * lk2[i]; } lam = expf(a) - expf(c) + LAM_INIT; }
    __syncthreads();
    float m1 = -INFINITY, m2 = -INFINITY;
    for (int j = tid; j < ke; j += 256) {
        const float* kp = kr + ((size_t)b * L + j) * 512 + h * 128;
        float a = 0.f, c = 0.f;
        for (int d = 0; d < 64; ++d) { a = fmaf(qs[d], kp[d], a); c = fmaf(qs[64 + d], kp[64 + d], c); }
        s1[j] = a; s2[j] = c; m1 = fmaxf(m1, a); m2 = fmaxf(m2, c);
    }
    m1 = block_max(m1, red); m2 = block_max(m2, red);
    float l1 = 0.f, l2 = 0.f;
    for (int j = tid; j < ke; j += 256) { const float e1 = expf(s1[j] - m1), e2 = expf(s2[j] - m2); s1[j] = e1; s2[j] = e2; l1 += e1; l2 += e2; }
    l1 = block_sum(l1, red); l2 = block_sum(l2, red);
    const float i1 = 1.0f / l1, i2 = lam / l2;
    for (int j = tid; j < ke; j += 256) s1[j] = s1[j] * i1 - s2[j] * i2;
    __syncthreads();
    const int d = tid & 127, half = tid >> 7;
    float o = 0.f;
    for (int j = half; j < ke; j += 2) o = fmaf(s1[j], proj[((size_t)b * L + j) * DIN + OFF_VA + h * 128 + d], o);
    if (half) part[d] = o;
    __syncthreads();
    if (!half) o += part[d]; else o = 0.f;
    const float ms = block_sum(half ? 0.f : o * o, red) * (1.0f / 128.0f);
    if (!half) y[((size_t)b * L + q) * D + h * 128 + d] = o * (1.0f / sqrtf(ms + RMS_EPS)) * subln_g[d] * (1.0f - LAM_INIT);
}

__global__ void __launch_bounds__(128) hgrn_k(const float* proj, const float* lbt, const float* norm_g, float* y) {
    __shared__ float sq[128], sf[128], sk[128], red[2];
    const int h = blockIdx.x, b = blockIdx.y, tid = threadIdx.x;
    float S[128];
#pragma unroll
    for (int k = 0; k < 128; ++k) S[k] = 0.f;
    float lb;
    { const float t0 = lbt[h * 128 + tid], t1 = lbt[512 + h * 128 + tid]; const float mx = fmaxf(t0, t1); const float e0 = expf(t0 - mx), e1 = expf(t1 - mx); lb = e0 / (e0 + e1); }
    const float ng = norm_g[tid];
    for (int t = 0; t < L; ++t) {
        const float* pr = proj + ((size_t)b * L + t) * DIN;
        const float qv = pr[OFF_QB + h * 128 + tid], z = pr[OFF_FB + h * 128 + tid], vv = pr[OFF_IB + h * 128 + tid], gv = pr[OFF_GB + h * 128 + tid];
        __syncthreads();
        sq[tid] = siluf_(qv) * 0.08838834764831845f;
        sf[tid] = lb + (1.0f - lb) * sigmoidf_(z);
        sk[tid] = (1.0f - lb) * sigmoidf_(-z);
        __syncthreads();
        float o = 0.f;
#pragma unroll
        for (int k = 0; k < 128; k += 4) {
            const float4 f4 = *(const float4*)&sf[k], k4 = *(const float4*)&sk[k], q4 = *(const float4*)&sq[k];
            S[k + 0] = fmaf(f4.x, S[k + 0], k4.x * vv); o = fmaf(q4.x, S[k + 0], o);
            S[k + 1] = fmaf(f4.y, S[k + 1], k4.y * vv); o = fmaf(q4.y, S[k + 1], o);
            S[k + 2] = fmaf(f4.z, S[k + 2], k4.z * vv); o = fmaf(q4.z, S[k + 2], o);
            S[k + 3] = fmaf(f4.w, S[k + 3], k4.w * vv); o = fmaf(q4.w, S[k + 3], o);
        }
        float ss = o * o;
        for (int off = 32; off > 0; off >>= 1) ss += __shfl_xor(ss, off);
        __syncthreads();
        if ((tid & 63) == 0) red[tid >> 6] = ss;
        __syncthreads();
        const float ms = (red[0] + red[1]) * (1.0f / 128.0f);
        y[((size_t)b * L + t) * D + 512 + h * 128 + tid] = o * (1.0f / sqrtf(ms + RMS_EPS)) * ng * siluf_(gv);
    }
}

__global__ void __launch_bounds__(256) router_k(const float* h1, const float* wr, const float* br, int* cnt, int* list, int* slotpos, float* gates) {
    __shared__ float lg[4][32];
    const int w = threadIdx.x >> 6, lane = threadIdx.x & 63, t = blockIdx.x * 4 + w;
    const int e = lane & 31, half = lane >> 5;
    const float* hr = h1 + (size_t)t * D;
    float a = 0.f;
    for (int d = half * 512; d < half * 512 + 512; ++d) a = fmaf(hr[d], wr[d * NE + e], a);
    a += __shfl_xor(a, 32);
    (void)lg;
    float v = (lane < 32) ? a + br[e] : -INFINITY;
    float val0 = 0.f, s = 0.f, myex = 0.f; int myidx = 0;
#pragma unroll
    for (int k = 0; k < 4; ++k) {
        float bv = v; int bi = lane;
        for (int o = 32; o > 0; o >>= 1) { const float ov = __shfl_xor(bv, o); const int oi = __shfl_xor(bi, o); if (ov > bv || (ov == bv && oi < bi)) { bv = ov; bi = oi; } }
        if (k == 0) val0 = bv;
        const float ex = expf(bv - val0); s += ex;
        if (lane == k) { myex = ex; myidx = bi; }
        if (lane == bi) v = -INFINITY;
    }
    if (lane < 4) {
        gates[t * 4 + lane] = myex / s;
        const int pos = atomicAdd(&cnt[myidx], 1);
        list[(size_t)myidx * T + pos] = t * 4 + lane;
        slotpos[t * 4 + lane] = (myidx << 16) | pos;
    }
}

__global__ void __launch_bounds__(256) final_k(const float* h1, const float* yexp, const int* cnt, const int* slotpos, const float* gates, const float* g, const float* bta, float* out) {
    __shared__ float red[8];
    const int b = blockIdx.x / SEQ, s = blockIdx.x % SEQ, t = b * L + NMETA + s;
    const float4 hv = *(const float4*)(h1 + (size_t)t * D + threadIdx.x * 4);
    float4 v = make_float4(ALPHA * hv.x, ALPHA * hv.y, ALPHA * hv.z, ALPHA * hv.w);
    float4 f = make_float4(0.f, 0.f, 0.f, 0.f);
    for (int k = 0; k < 4; ++k) {
        const int sp = slotpos[t * 4 + k], e = sp >> 16, pos = sp & 0xffff;
        int off = 0; for (int i = 0; i < e; ++i) off += cnt[i];
        const float gt = gates[t * 4 + k];
        const float4 yv = *(const float4*)(yexp + (size_t)(off + pos) * D + threadIdx.x * 4);
        f.x += yv.x * gt; f.y += yv.y * gt; f.z += yv.z * gt; f.w += yv.w * gt;
    }
    v.x += f.x; v.y += f.y; v.z += f.z; v.w += f.w;
    const float mu = block_sum(v.x + v.y + v.z + v.w, red) * (1.0f / D);
    const float d0 = v.x - mu, d1 = v.y - mu, d2 = v.z - mu, d3 = v.w - mu;
    const float var = block_sum(d0 * d0 + d1 * d1 + d2 * d2 + d3 * d3, red) * (1.0f / D);
    const float rs = 1.0f / sqrtf(var + LN_EPS);
    const float4 gv = *(const float4*)(g + threadIdx.x * 4), bv = *(const float4*)(bta + threadIdx.x * 4);
    float4 o; o.x = d0 * rs * gv.x + bv.x; o.y = d1 * rs * gv.y + bv.y; o.z = d2 * rs * gv.z + bv.z; o.w = d3 * rs * gv.w + bv.w;
    *(float4*)(out + (size_t)blockIdx.x * D + threadIdx.x * 4) = o;
}
}

extern "C" void kernel_launch(void* const* d_in, const int* in_sizes, int n_in, void* d_out, int out_size, void* d_ws, size_t ws_size, hipStream_t stream) {
    const float* x = (const float*)d_in[0]; const float* meta = (const float*)d_in[1];
    const float* ln_emb_g = (const float*)d_in[2]; const float* ln_emb_b = (const float*)d_in[3];
    const float* w_in = (const float*)d_in[4];
    const float* lq1 = (const float*)d_in[5]; const float* lk1 = (const float*)d_in[6]; const float* lq2 = (const float*)d_in[7]; const float* lk2 = (const float*)d_in[8];
    const float* subln_g = (const float*)d_in[9]; const float* lbt = (const float*)d_in[10]; const float* hnorm_g = (const float*)d_in[11];
    const float* w_out = (const float*)d_in[12]; const float* ln1_g = (const float*)d_in[13]; const float* ln1_b = (const float*)d_in[14];
    const float* w_router = (const float*)d_in[15]; const float* b_router = (const float*)d_in[16];
    const float* w_gu = (const float*)d_in[17]; const float* b_gu = (const float*)d_in[18];
    const float* w_dn = (const float*)d_in[19]; const float* b_dn = (const float*)d_in[20];
    const float* ln2_g = (const float*)d_in[21]; const float* ln2_b = (const float*)d_in[22];
    float* out = (float*)d_out;

    char* ws = (char*)d_ws; size_t o = 0;
    auto take = [&](size_t bytes) { char* p = ws + o; o += (bytes + 255) & ~(size_t)255; return p; };
    int* cnt = (int*)take(256);
    int* list = (int*)take((size_t)NE * T * 4);
    int* slotpos = (int*)take((size_t)NA * 4);
    float* gates = (float*)take((size_t)NA * 4);
    float* h0 = (float*)take((size_t)T * D * 4);
    float* h1 = (float*)take((size_t)T * D * 4);
    float* yexp = (float*)take((size_t)NA * D * 4);
    char* R = take((size_t)NA * D * 4 + (size_t)T * D * 4);
    float* proj = (float*)R;
    float* ymix = (float*)(R + (size_t)T * DIN * 4);
    float* qr = (float*)take((size_t)T * 512 * 4);
    float* kr = (float*)take((size_t)T * 512 * 4);
    float* pre1 = (float*)take((size_t)T * D * 4);
    float* act = (float*)R;
    (void)ws_size; (void)in_sizes; (void)n_in; (void)out_size;

    hipMemsetAsync(cnt, 0, 256, stream);
    ln_rows_k<<<T, 256, 0, stream>>>(x, meta, nullptr, ln_emb_g, ln_emb_b, h0, 0);
    { GemmIn f{h0, w_in, proj}; sgemm_k<GemmIn><<<dim3(DIN / 64, (T + 63) / 64, 1), 256, 0, stream>>>(f); }
    rope_k<<<T, 256, 0, stream>>>(proj, qr, kr);
    attn_k<<<dim3(L, 4, NB), 256, 0, stream>>>(qr, kr, proj, lq1, lk1, lq2, lk2, subln_g, ymix);
    hgrn_k<<<dim3(4, NB), 128, 0, stream>>>(proj, lbt, hnorm_g, ymix);
    { GemmOut f{ymix, w_out, h0, pre1}; sgemm_k<GemmOut><<<dim3(D / 64, (T + 63) / 64, 1), 256, 0, stream>>>(f); }
    ln_rows_k<<<T, 256, 0, stream>>>(nullptr, nullptr, pre1, ln1_g, ln1_b, h1, 1);
    router_k<<<T / 4, 256, 0, stream>>>(h1, w_router, b_router, cnt, list, slotpos, gates);
    { GemmGU f{h1, w_gu, b_gu, cnt, list, act}; sgemm_k<GemmGU><<<dim3(2 * D / 64, (T + 63) / 64, NE), 256, 0, stream>>>(f); }
    { GemmDN f{act, w_dn, b_dn, cnt, yexp}; sgemm_k<GemmDN><<<dim3(D / 64, (T + 63) / 64, NE), 256, 0, stream>>>(f); }
    final_k<<<NB * SEQ, 256, 0, stream>>>(h1, yexp, cnt, slotpos, gates, ln2_g, ln2_b, out);
}
```

```cpp
#include <hip/hip_runtime.h>
#include <cstdio>
#include <cstdint>
namespace pg8 {
#define PG8_LAS __attribute__((address_space(3)))
typedef unsigned short bf16_t;
typedef short bf16x8 __attribute__((ext_vector_type(8)));
typedef float f32x4 __attribute__((ext_vector_type(4)));
typedef unsigned u32x4 __attribute__((ext_vector_type(4)));
constexpr int BM = 256, BK = 64, HALF = 128, HTB = HALF * BK * 2  , STAGE_BYTES = 8 * HTB, NXCD = 8, WGM = 8;

__host__ __device__ __forceinline__ int lds_byte(int r, int c) { const int st = (r >> 4) * 2 + (c >> 5), rr = r & 15, cc = c & 31, ob = rr * 64 + cc * 2; return st * 1024 + (ob ^ (((ob >> 9) & 1) << 5)); }
__host__ __device__ __forceinline__ void stage_rc(int b, int& R, int& C) { const int st = b / 1024, sb = b % 1024, swz = sb ^ (((sb >> 9) & 1) << 5); R = (st >> 1) * 16 + swz / 64; C = (st & 1) * 32 + (swz % 64) / 2; }
__host__ __device__ __forceinline__ int perm32(int rho) { const int n = rho >> 4, i = rho & 15; return 8 * (i >> 2) + 4 * n + (i & 3); }

struct Unit { int pm, pn, e; };
struct Gemm { const bf16_t* A; const bf16_t* Bt; int M, N, K; };

template <bool AMAP> struct StaticOrderT {
    static constexpr bool UNIFORM_AOFF = true;
    __device__ __forceinline__ void a_ready(const Unit&) const {}
    int nM, nN, nwg, G, c;
    __host__ __device__ void init(int M, int N, int G_, int c_) { nM = M / BM; nN = N / BM; nwg = nM * nN; G = G_; c = c_; }
    __host__ __device__ bool next(int i, Unit& u) const {
        const long L = (long)i * G + c; if (L >= nwg) return false;
        int wgid = (int)L; { const int q = nwg / NXCD, r = nwg % NXCD, xcd = wgid % NXCD, off = wgid / NXCD; wgid = (xcd < r ? xcd * (q + 1) : r * (q + 1) + (xcd - r) * q) + off; }
        const int nig = WGM * nN, gid = wgid / nig, fm = gid * WGM, gsz = (nM - fm) < WGM ? (nM - fm) : WGM;
        u.pm = fm + ((wgid % nig) % gsz); u.pn = (wgid % nig) / gsz; u.e = 0; return true;
    }
    __device__ __forceinline__ const char* a_base(const Gemm& g, const Unit& u) const { const size_t row = AMAP ? (size_t)(u.pm >> 3) * 2112 + 64 + (size_t)(u.pm & 7) * 256 : (size_t)u.pm * 256; return (const char*)g.A + row * g.K * 2; }
    __device__ __forceinline__ const char* b_base(const Gemm& g, const Unit& u) const { return (const char*)g.Bt + (size_t)u.pn * 256 * g.K * 2; }
    __device__ __forceinline__ void a_offs(const Gemm& g, const Unit&, int tid, unsigned (&vo)[2][2]) const {
#pragma unroll
        for (int i = 0; i < 2; ++i) { int R, C; stage_rc(tid * 16 + i * 8192, R, C); vo[0][i] = (unsigned)(R * g.K + C) * 2u; vo[1][i] = (unsigned)((R + HALF) * g.K + C) * 2u; }
    }
};
typedef StaticOrderT<false> StaticOrder;
template <bool GATHER> struct GroupedOrder {
    static constexpr bool UNIFORM_AOFF = !GATHER;
    __device__ __forceinline__ void a_ready(const Unit&) const {}
    const PG8_LAS int* tpre; const int* cnt; const int* list; int nct_shift, G, c; size_t bstride;
    __device__ __forceinline__ bool next(int i, Unit& u) const {
        const int L = i * G + c, ntot = tpre[32]; const int tile = L >> nct_shift;
        if (tile >= ntot) return false;
        int e = 0;
        for (int k = 1; k < 32; ++k) e += (tile >= tpre[k]) ? 1 : 0;
        u.pm = tile; u.pn = L & ((1 << nct_shift) - 1); u.e = e; return true;
    }
    __device__ __forceinline__ const char* a_base(const Gemm& g, const Unit& u) const { return GATHER ? (const char*)g.A : (const char*)g.A + (size_t)u.pm * 256 * g.K * 2; }
    __device__ __forceinline__ const char* b_base(const Gemm& g, const Unit& u) const { return (const char*)g.Bt + (size_t)u.e * bstride + (size_t)u.pn * 256 * g.K * 2; }
    __device__ __forceinline__ void a_offs(const Gemm& g, const Unit& u, int tid, unsigned (&vo)[2][2]) const {
#pragma unroll
        for (int i = 0; i < 2; ++i) { int R, C; stage_rc(tid * 16 + i * 8192, R, C);
            if (GATHER) {
                const int n = cnt[u.e], lr = (u.pm - tpre[u.e]) * 256 + R;
                const int t0 = lr < n ? list[u.e * 16384 + lr] : 0, t1 = lr + HALF < n ? list[u.e * 16384 + lr + HALF] : 0;
                vo[0][i] = (unsigned)(t0 * g.K + C) * 2u; vo[1][i] = (unsigned)(t1 * g.K + C) * 2u;
            } else { vo[0][i] = (unsigned)(R * g.K + C) * 2u; vo[1][i] = (unsigned)((R + HALF) * g.K + C) * 2u; }
        }
    }
};

struct SplitOrder {
    static constexpr bool UNIFORM_AOFF = true;
    const PG8_LAS int* tpre; unsigned* gctr; int G, vcu, R; size_t bstride;
    __device__ __forceinline__ int pos2tile(int p, int ntiles) const {
        const int q = R >> 3, nfull = ntiles >> 5, rem = ntiles & 31, nef = 32 - q;
        const int E1 = nfull * nef, Er = rem > q ? rem - q : 0;
        if (p < E1) return 32 * (p / nef) + q + p % nef;
        if (p < E1 + Er) return 32 * nfull + q + (p - E1);
        const int p2 = p - E1 - Er;
        if (p2 < nfull * q) return 32 * (p2 / q) + p2 % q;
        return 32 * nfull + (p2 - nfull * q);
    }
    __device__ __forceinline__ bool next(int i, Unit& u) const {
        const int ntiles = tpre[32], rank = vcu >= R ? vcu - R : vcu + (G - R);
        const int L = i * G + rank, p = L >> 2;
        if (p >= ntiles) return false;
        const int tile = pos2tile(p, ntiles);
        int e = 0;
        for (int k = 1; k < 32; ++k) e += (tile >= tpre[k]) ? 1 : 0;
        u.pm = tile; u.pn = L & 3; u.e = e; return true;
    }
    mutable unsigned seen;
    __device__ __forceinline__ void a_ready(const Unit& u) const {
        const bool late = (u.pm & 31) < (R >> 3);
        const unsigned bit = late ? 2u : 1u;
        if (seen & bit) return;
        seen |= bit;
        if (threadIdx.x < 64) {
            const unsigned target = late ? (unsigned)R : (unsigned)(G - R);
            unsigned* c = gctr + (late ? 64 : 0); unsigned sp = 0;
            while ((unsigned)__builtin_amdgcn_readfirstlane(__hip_atomic_load(c, __ATOMIC_RELAXED, __HIP_MEMORY_SCOPE_AGENT)) < target && ++sp < (1u << 22)) __builtin_amdgcn_s_sleep(2);
            __builtin_amdgcn_fence(__ATOMIC_ACQUIRE, "agent");
            asm volatile("s_waitcnt vmcnt(0)" ::: "memory");
        }
        asm volatile("" ::: "memory"); __builtin_amdgcn_s_barrier(); asm volatile("" ::: "memory");
    }
    __device__ __forceinline__ const char* a_base(const Gemm& g, const Unit& u) const { return (const char*)g.A + (size_t)u.pm * 256 * g.K * 2; }
    __device__ __forceinline__ const char* b_base(const Gemm& g, const Unit& u) const { return (const char*)g.Bt + (size_t)u.e * bstride + (size_t)u.pn * 256 * g.K * 2; }
    __device__ __forceinline__ void a_offs(const Gemm& g, const Unit&, int tid, unsigned (&vo)[2][2]) const {
#pragma unroll
        for (int i = 0; i < 2; ++i) { int Rr, C; stage_rc(tid * 16 + i * 8192, Rr, C); vo[0][i] = (unsigned)(Rr * g.K + C) * 2u; vo[1][i] = (unsigned)((Rr + HALF) * g.K + C) * 2u; }
    }
};

__device__ __forceinline__ unsigned cvt_pk_bf16(float lo, float hi) { unsigned r; asm volatile("v_cvt_pk_bf16_f32 %0, %1, %2" : "=v"(r) : "v"(lo), "v"(hi)); return r; }
typedef float f32x2 __attribute__((ext_vector_type(2)));

typedef int v8i32_t __attribute__((ext_vector_type(8)));
typedef int v4i32_t __attribute__((ext_vector_type(4)));
__device__ __forceinline__ v8i32_t cat8(bf16x8 lo, bf16x8 hi) { const v4i32_t a = __builtin_bit_cast(v4i32_t, lo), b = __builtin_bit_cast(v4i32_t, hi); return __builtin_shufflevector(a, b, 0, 1, 2, 3, 4, 5, 6, 7); }
__device__ __forceinline__ unsigned pk4_fp8(float a, float b, float c, float d) {
    a = fminf(fmaxf(a, -448.f), 448.f); b = fminf(fmaxf(b, -448.f), 448.f); c = fminf(fmaxf(c, -448.f), 448.f); d = fminf(fmaxf(d, -448.f), 448.f);
    int p = __builtin_amdgcn_cvt_pk_fp8_f32(a, b, 0, false); p = __builtin_amdgcn_cvt_pk_fp8_f32(c, d, p, true); return (unsigned)p;
}
__device__ __forceinline__ float fast_sigmoid(float x) { return __builtin_amdgcn_rcpf(1.0f + __builtin_amdgcn_exp2f(-1.4426950408889634f * x)); }
typedef unsigned u32x2 __attribute__((ext_vector_type(2)));
constexpr int LPAD = 2112;
struct EpiProj {
    static constexpr bool PERM = true, AFTER_DRAIN = false;
    bf16_t *QA, *KA, *VA, *QB, *VB, *GB; float* LF; const float* rope; const float* lb;
    __device__ __forceinline__ void operator()(const f32x4 (&acc)[2][2][4][2], const Unit& u, int wr, int wc, int fr, int fq) const {
        const int g = u.pn >> 1;
        const int colg = (u.pn & 1) * 256 + wc * 32 + 8 * fq;
        const int row0 = u.pm * BM + wr * 64 + fr;
        if (g <= 1) {
            bf16_t* O = g == 0 ? QA : KA; const float sc = g == 0 ? 0.125f * 1.4426950408889634f : 1.0f;
            const int j = (wc & 1) * 16 + 4 * fq;
            f32x4 cs[8][2];
#pragma unroll
            for (int rg = 0; rg < 8; ++rg) { const int t = (row0 + (rg >> 2) * HALF + (rg & 3) * 16) % LPAD; const float* rp = rope + (size_t)(t * 32 + j) * 2; cs[rg][0] = *(const f32x4*)rp; cs[rg][1] = *(const f32x4*)(rp + 4); }
#pragma unroll
            for (int rg = 0; rg < 8; ++rg) {
                const int ai = rg >> 2, m = rg & 3, r = row0 + ai * HALF + m * 16;
                const f32x4 cs0 = cs[rg][0], cs1 = cs[rg][1];
#pragma unroll
                for (int bj = 0; bj < 2; ++bj) {
                    const f32x4 v0 = acc[ai][bj][m][0], v1 = acc[ai][bj][m][1];
                    u32x4 w;
                    w.x = cvt_pk_bf16((v0[0] * cs0[0] - v0[1] * cs0[1]) * sc, (v0[1] * cs0[0] + v0[0] * cs0[1]) * sc);
                    w.y = cvt_pk_bf16((v0[2] * cs0[2] - v0[3] * cs0[3]) * sc, (v0[3] * cs0[2] + v0[2] * cs0[3]) * sc);
                    w.z = cvt_pk_bf16((v1[0] * cs1[0] - v1[1] * cs1[1]) * sc, (v1[1] * cs1[0] + v1[0] * cs1[1]) * sc);
                    w.w = cvt_pk_bf16((v1[2] * cs1[2] - v1[3] * cs1[3]) * sc, (v1[3] * cs1[2] + v1[2] * cs1[3]) * sc);
                    *(u32x4*)(O + (size_t)r * 512 + colg + bj * HALF) = w;
                }
            }
        } else if (g == 4) {
            f32x4 l0[2], l1[2];
#pragma unroll
            for (int bj = 0; bj < 2; ++bj) { l0[bj] = *(const f32x4*)(lb + colg + bj * HALF); l1[bj] = *(const f32x4*)(lb + colg + bj * HALF + 4); }
#pragma unroll
            for (int ai = 0; ai < 2; ++ai)
#pragma unroll
                for (int m = 0; m < 4; ++m) {
                    const int r = row0 + ai * HALF + m * 16;
#pragma unroll
                    for (int bj = 0; bj < 2; ++bj) {
                        const f32x4 v0 = acc[ai][bj][m][0], v1 = acc[ai][bj][m][1]; f32x4 o0, o1;
#pragma unroll
                        for (int e = 0; e < 4; ++e) {
                            o0[e] = __builtin_amdgcn_logf(l0[bj][e] + (1.0f - l0[bj][e]) * fast_sigmoid(v0[e]));
                            o1[e] = __builtin_amdgcn_logf(l1[bj][e] + (1.0f - l1[bj][e]) * fast_sigmoid(v1[e]));
                        }
                        float* p = LF + (size_t)r * 512 + colg + bj * HALF;
                        *(f32x4*)p = o0; *(f32x4*)(p + 4) = o1;
                    }
                }
        } else {
            bf16_t* O = g == 2 ? VA : (g == 3 ? QB : (g == 5 ? VB : GB));
            const int mode = (g == 3) ? 1 : (g == 6 ? 2 : 0);
#pragma unroll
            for (int ai = 0; ai < 2; ++ai)
#pragma unroll
                for (int m = 0; m < 4; ++m) {
                    const int r = row0 + ai * HALF + m * 16;
#pragma unroll
                    for (int bj = 0; bj < 2; ++bj) {
                        f32x4 v0 = acc[ai][bj][m][0], v1 = acc[ai][bj][m][1];
                        if (mode) {
                            const float sc = mode == 1 ? 0.08838834764831845f : 1.0f;
#pragma unroll
                            for (int e = 0; e < 4; ++e) { v0[e] = v0[e] * fast_sigmoid(v0[e]) * sc; v1[e] = v1[e] * fast_sigmoid(v1[e]) * sc; }
                        }
                        u32x4 w; w.x = cvt_pk_bf16(v0[0], v0[1]); w.y = cvt_pk_bf16(v0[2], v0[3]); w.z = cvt_pk_bf16(v1[0], v1[1]); w.w = cvt_pk_bf16(v1[2], v1[3]);
                        *(u32x4*)(O + (size_t)r * 512 + colg + bj * HALF) = w;
                    }
                }
        }
    }
};


struct EpiOut {
    static constexpr bool PERM = false, AFTER_DRAIN = false;
    const float* x; const float* stats; const float* g; const float* b; float* pre1;
    __device__ __forceinline__ void operator()(const f32x4 (&acc)[2][2][4][2], const Unit& u, int wr, int wc, int fr, int fq) const {
        const int col0 = u.pn * BM + wc * 32 + 4 * fq;
        const int row0 = u.pm * BM + wr * 64 + fr;
        f32x4 gv[2][2], bv[2][2];
#pragma unroll
        for (int bj = 0; bj < 2; ++bj)
#pragma unroll
            for (int n = 0; n < 2; ++n) { const int c = col0 + bj * HALF + n * 16; gv[bj][n] = *(const f32x4*)(g + c); bv[bj][n] = *(const f32x4*)(b + c); }
        f32x4 xb[2][2][2]; f32x2 st[2];
        { const size_t r = (size_t)row0; st[0] = *(const f32x2*)(stats + 2 * r); const float* xr = x + r * 1024 + col0;
#pragma unroll
          for (int bj = 0; bj < 2; ++bj)
#pragma unroll
              for (int n = 0; n < 2; ++n) xb[0][bj][n] = *(const f32x4*)(xr + bj * HALF + n * 16); }
#pragma unroll
        for (int rg = 0; rg < 8; ++rg) {
            if (rg + 1 < 8) { const size_t r = (size_t)(row0 + ((rg + 1) >> 2) * HALF + ((rg + 1) & 3) * 16); st[(rg + 1) & 1] = *(const f32x2*)(stats + 2 * r); const float* xr = x + r * 1024 + col0;
#pragma unroll
                for (int bj = 0; bj < 2; ++bj)
#pragma unroll
                    for (int n = 0; n < 2; ++n) xb[(rg + 1) & 1][bj][n] = *(const f32x4*)(xr + bj * HALF + n * 16); }
            const int ai = rg >> 2, m = rg & 3;
            const float mu = st[rg & 1].x, rs = st[rg & 1].y;
            float* pr = pre1 + (size_t)(row0 + ai * HALF + m * 16) * 1024 + col0;
#pragma unroll
            for (int bj = 0; bj < 2; ++bj)
#pragma unroll
                for (int n = 0; n < 2; ++n) *(f32x4*)(pr + bj * HALF + n * 16) = ((xb[rg & 1][bj][n] - mu) * rs * gv[bj][n] + bv[bj][n]) * 1.189207115002721f + acc[ai][bj][m][n];
        }
    }
};
template <bool OUT8> struct EpiGU {
    static constexpr bool PERM = true, AFTER_DRAIN = false;
    const float* bias; bf16_t* act; float scale;
    __device__ __forceinline__ static float swiglu(float gt, float up) { gt = fminf(gt, 7.0f); up = fminf(fmaxf(up, -7.0f), 7.0f); return (up + 1.0f) * gt * fast_sigmoid(1.702f * gt); }
    __device__ __forceinline__ void operator()(const f32x4 (&acc)[2][2][4][2], const Unit& u, int wr, int wc, int fr, int fq) const {
        const int col0 = u.pn * BM + wc * 32 + 8 * fq;
        const float* bb = bias + (size_t)u.e * 2048 + col0;
        f32x4 b0[2], b1[2];
#pragma unroll
        for (int bj = 0; bj < 2; ++bj) { b0[bj] = *(const f32x4*)(bb + bj * HALF); b1[bj] = *(const f32x4*)(bb + bj * HALF + 4); }
        if constexpr (OUT8) {
            const int msel = fq >> 1, bsel = fq & 1;
#pragma unroll
            for (int ai = 0; ai < 2; ++ai)
#pragma unroll
                for (int mp = 0; mp < 4; mp += 2) {
                    unsigned P[2][2];
#pragma unroll
                    for (int mm = 0; mm < 2; ++mm)
#pragma unroll
                        for (int bj = 0; bj < 2; ++bj) {
                            const f32x4 v0 = acc[ai][bj][mp + mm][0] * scale + b0[bj], v1 = acc[ai][bj][mp + mm][1] * scale + b1[bj];
                            P[mm][bj] = pk4_fp8(swiglu(v0[0], v0[1]), swiglu(v0[2], v0[3]), swiglu(v1[0], v1[1]), swiglu(v1[2], v1[3]));
                        }
                    const auto s0 = __builtin_amdgcn_permlane16_swap(P[0][0], P[0][1], false, false);
                    const auto s1 = __builtin_amdgcn_permlane16_swap(P[1][0], P[1][1], false, false);
                    const auto t0 = __builtin_amdgcn_permlane32_swap(s0[0], s1[0], false, false);
                    const auto t1 = __builtin_amdgcn_permlane32_swap(s0[1], s1[1], false, false);
                    u32x4 w; w.x = t0[0]; w.y = t1[0]; w.z = t0[1]; w.w = t1[1];
                    const size_t r = (size_t)u.pm * BM + ai * HALF + wr * 64 + (mp + msel) * 16 + fr;
                    *(u32x4*)((unsigned char*)act + r * 1024 + u.pn * 128 + wc * 16 + bsel * 64) = w;
                }
        } else {
#pragma unroll
            for (int ai = 0; ai < 2; ++ai)
#pragma unroll
                for (int m = 0; m < 4; ++m) {
                    const size_t r = (size_t)u.pm * BM + ai * HALF + wr * 64 + m * 16 + fr;
#pragma unroll
                    for (int bj = 0; bj < 2; ++bj) {
                        const f32x4 v0 = acc[ai][bj][m][0] * scale + b0[bj], v1 = acc[ai][bj][m][1] * scale + b1[bj];
                        u32x2 w; w.x = cvt_pk_bf16(swiglu(v0[0], v0[1]), swiglu(v0[2], v0[3])); w.y = cvt_pk_bf16(swiglu(v1[0], v1[1]), swiglu(v1[2], v1[3]));
                        *(u32x2*)(act + r * 1024 + ((col0 + bj * HALF) >> 1)) = w;
                    }
                }
        }
    }
};
template <bool OUT8> struct EpiDN {
    static constexpr bool PERM = true, AFTER_DRAIN = false;
    const float* bias; bf16_t* ye; float scale, oscale;
    __device__ __forceinline__ void operator()(const f32x4 (&acc)[2][2][4][2], const Unit& u, int wr, int wc, int fr, int fq) const {
        const int col0 = u.pn * BM + wc * 32 + 8 * fq;
        const float* bb = bias + (size_t)u.e * 1024 + col0;
        f32x4 b0[2], b1[2];
#pragma unroll
        for (int bj = 0; bj < 2; ++bj) { b0[bj] = *(const f32x4*)(bb + bj * HALF); b1[bj] = *(const f32x4*)(bb + bj * HALF + 4); }
#pragma unroll
        for (int ai = 0; ai < 2; ++ai)
#pragma unroll
            for (int m = 0; m < 4; ++m) {
                const size_t r = (size_t)u.pm * BM + ai * HALF + wr * 64 + m * 16 + fr;
                if constexpr (OUT8) {
                    unsigned A[2][2];
#pragma unroll
                    for (int bj = 0; bj < 2; ++bj) {
                        const f32x4 v0 = (acc[ai][bj][m][0] * scale + b0[bj]) * oscale, v1 = (acc[ai][bj][m][1] * scale + b1[bj]) * oscale;
                        A[bj][0] = pk4_fp8(v0[0], v0[1], v0[2], v0[3]); A[bj][1] = pk4_fp8(v1[0], v1[1], v1[2], v1[3]);
                    }
                    const auto s0 = __builtin_amdgcn_permlane16_swap(A[0][0], A[1][0], false, false);
                    const auto s1 = __builtin_amdgcn_permlane16_swap(A[0][1], A[1][1], false, false);
                    u32x4 w; w.x = s0[0]; w.y = s1[0]; w.z = s0[1]; w.w = s1[1];
                    *(u32x4*)((unsigned char*)ye + r * 1024 + u.pn * BM + wc * 32 + (fq & 1) * HALF + 16 * (fq >> 1)) = w;
                } else {
#pragma unroll
                    for (int bj = 0; bj < 2; ++bj) {
                        const f32x4 v0 = acc[ai][bj][m][0] * scale + b0[bj], v1 = acc[ai][bj][m][1] * scale + b1[bj];
                        u32x4 w; w.x = cvt_pk_bf16(v0[0], v0[1]); w.y = cvt_pk_bf16(v0[2], v0[3]); w.z = cvt_pk_bf16(v1[0], v1[1]); w.w = cvt_pk_bf16(v1[2], v1[3]);
                        *(u32x4*)(ye + r * 1024 + col0 + bj * HALF) = w;
                    }
                }
            }
    }
};

template <class Epi, class Sched, bool ALIGN_EPI = false, bool FP8 = false>
__device__ __forceinline__ void gemm_phase(PG8_LAS unsigned char* lds, const Gemm g, const Sched& S, const Epi& E) {
    const int tid = threadIdx.x, wid = __builtin_amdgcn_readfirstlane(tid >> 6), lane = tid & 63, wr = wid >> 2, wc = wid & 3, fr = lane & 15, fq = lane >> 4;
    const int K = g.K, nt = K / BK;
    unsigned voffB[2];
#pragma unroll
    for (int i = 0; i < 2; ++i) { int R, C; stage_rc(tid * 16 + i * 8192, R, C); const int Rb = Epi::PERM ? ((R & ~31) + perm32(R & 31)) : R; voffB[i] = (unsigned)(Rb * K + C) * 2u; }
    const size_t kstep = (size_t)(BK * 2);
    const size_t hstep = (size_t)HALF * K * 2;
    const unsigned ldsw = (unsigned)wid * 1024u;
    const int aoff = lds_byte(wr * 64 + fr, fq * 8), boff = lds_byte(wc * 32 + fr, fq * 8);
#define PG8_SA(b, h) (((b) * 2 + (h)) * HTB)
#define PG8_SB(b, h) ((4 + (b) * 2 + (h)) * HTB)
#define PG8_STAGE2(bufoff, gbase, v0, v1) do { \
        __builtin_amdgcn_global_load_lds((const unsigned*)((const char*)(gbase) + (v0)), (PG8_LAS unsigned*)(lds + (bufoff) + ldsw), 16, 0, 0); \
        __builtin_amdgcn_global_load_lds((const unsigned*)((const char*)(gbase) + (v1)), (PG8_LAS unsigned*)(lds + (bufoff) + ldsw + 8192), 16, 0, 0); } while (0)
#define PG8_STAGEB(bufoff, gbase) PG8_STAGE2(bufoff, gbase, voffB[0], voffB[1])
#define PG8_LDA(dst, b, h) do { _Pragma("unroll") for (int m = 0; m < 4; ++m) _Pragma("unroll") for (int k = 0; k < 2; ++k) dst[m][k] = *(const PG8_LAS bf16x8*)(lds + PG8_SA(b, h) + aoff + m * 2048 + k * 1024); } while (0)
#define PG8_LDB(dst, b, h) do { _Pragma("unroll") for (int n = 0; n < 2; ++n) _Pragma("unroll") for (int k = 0; k < 2; ++k) dst[n][k] = *(const PG8_LAS bf16x8*)(lds + PG8_SB(b, h) + boff + n * 2048 + k * 1024); } while (0)
#define PG8_MMA(ai, bj, At, Bt) do { __builtin_amdgcn_s_setprio(1); _Pragma("unroll") for (int m = 0; m < 4; ++m) _Pragma("unroll") for (int n = 0; n < 2; ++n) _Pragma("unroll") for (int k = 0; k < 2; ++k) \
        acc[ai][bj][m][n] = __builtin_amdgcn_mfma_f32_16x16x32_bf16(Bt[n][k], At[m][k], acc[ai][bj][m][n], 0, 0, 0); __builtin_amdgcn_s_setprio(0); } while (0)
#define PG8_MMA8(ai, bj, At, Bt) do { __builtin_amdgcn_s_setprio(1); _Pragma("unroll") for (int m = 0; m < 4; ++m) _Pragma("unroll") for (int n = 0; n < 2; ++n) \
        asm volatile("v_mfma_scale_f32_16x16x128_f8f6f4 %0, %1, %2, %0, %3, %3 op_sel_hi:[0,0,0]" : "+v"(acc[ai][bj][m][n]) : "v"(cat8(Bt[n][0], Bt[n][1])), "v"(cat8(At[m][0], At[m][1])), "v"(0x7f7f7f7f)); \
        __builtin_amdgcn_s_setprio(0); } while (0)
#define PG8_MM(ai, bj, At, Bt) do { if constexpr (FP8) PG8_MMA8(ai, bj, At, Bt); else PG8_MMA(ai, bj, At, Bt); } while (0)
#define PG8_WAIT_V(n) asm volatile("s_waitcnt vmcnt(" #n ")" ::: "memory")
#define PG8_WAIT_L(n) asm volatile("s_waitcnt lgkmcnt(" #n ")" ::: "memory")
#define PG8_BAR __builtin_amdgcn_s_barrier()
#define PG8_SCHED __builtin_amdgcn_sched_barrier(0)
    Unit cur, nxt; int ui = 0;
    if (!S.next(0, cur)) return;
    f32x4 acc[2][2][4][2];
#pragma unroll
    for (int a = 0; a < 2; ++a)
#pragma unroll
        for (int b = 0; b < 2; ++b)
#pragma unroll
            for (int m = 0; m < 4; ++m)
#pragma unroll
                for (int n = 0; n < 2; ++n) acc[a][b][m][n] = (f32x4){0.f, 0.f, 0.f, 0.f};
    bf16x8 At[4][2], B0[2][2], B1[2][2];
    unsigned vc[2][2], vn[2][2];
    S.a_ready(cur);
    S.a_offs(g, cur, tid, vc);
    const char* cA = S.a_base(g, cur); const char* cB = S.b_base(g, cur);
    PG8_STAGEB(PG8_SB(0, 0), cB); PG8_STAGEB(PG8_SB(0, 1), cB + hstep); PG8_STAGE2(PG8_SA(0, 0), cA, vc[0][0], vc[0][1]); PG8_STAGE2(PG8_SA(0, 1), cA, vc[1][0], vc[1][1]);
    if (wr == 1) PG8_BAR;
    PG8_WAIT_V(2); PG8_BAR;
    PG8_STAGEB(PG8_SB(1, 0), cB + kstep); PG8_STAGE2(PG8_SA(1, 0), cA + kstep, vc[0][0], vc[0][1]); PG8_STAGEB(PG8_SB(1, 1), cB + hstep + kstep);
    PG8_WAIT_V(6); PG8_BAR;
    for (;;) {
        const bool has_next = S.next(ui + 1, nxt);
        const char* nA = cA; const char* nB = cB;
        if (has_next) { nA = S.a_base(g, nxt); nB = S.b_base(g, nxt); if constexpr (!Sched::UNIFORM_AOFF) S.a_offs(g, nxt, tid, vn); }
        else if constexpr (!Sched::UNIFORM_AOFF) { vn[0][0] = vc[0][0]; vn[0][1] = vc[0][1]; vn[1][0] = vc[1][0]; vn[1][1] = vc[1][1]; }
#pragma unroll 1
        for (int t = 0; t < nt; t += 2) {
            const bool last = (t == nt - 2);
            if (last && has_next) S.a_ready(nxt);
            const char* a1 = cA + (size_t)(t + 1) * kstep;
            const char* a2 = last ? nA : cA + (size_t)(t + 2) * kstep; const char* b2 = last ? nB : cB + (size_t)(t + 2) * kstep;
            const char* a3 = a2 + kstep; const char* b3 = b2 + kstep;
            const unsigned w00 = (!Sched::UNIFORM_AOFF && last) ? vn[0][0] : vc[0][0], w01 = (!Sched::UNIFORM_AOFF && last) ? vn[0][1] : vc[0][1], w10 = (!Sched::UNIFORM_AOFF && last) ? vn[1][0] : vc[1][0], w11 = (!Sched::UNIFORM_AOFF && last) ? vn[1][1] : vc[1][1];
            PG8_LDB(B0, 0, 0); PG8_LDB(B1, 0, 1); PG8_SCHED; PG8_LDA(At, 0, 0); PG8_STAGE2(PG8_SA(1, 1), a1, vc[1][0], vc[1][1]);
            PG8_WAIT_V(8); PG8_WAIT_L(0); PG8_BAR; PG8_MM(0, 0, At, B0); PG8_MM(0, 1, At, B1); PG8_BAR; PG8_SCHED;
            PG8_LDA(At, 0, 1); PG8_STAGEB(PG8_SB(0, 0), b2); PG8_STAGEB(PG8_SB(0, 1), b2 + hstep); PG8_STAGE2(PG8_SA(0, 0), a2, w00, w01);
            PG8_WAIT_V(8); PG8_WAIT_L(0); PG8_BAR; PG8_MM(1, 0, At, B0); PG8_MM(1, 1, At, B1); PG8_BAR; PG8_SCHED;
            PG8_LDB(B0, 1, 0); PG8_LDB(B1, 1, 1); PG8_SCHED; PG8_LDA(At, 1, 0); PG8_STAGE2(PG8_SA(0, 1), a2, w10, w11);
            PG8_WAIT_V(8); PG8_WAIT_L(0); PG8_BAR; PG8_MM(0, 0, At, B0); PG8_MM(0, 1, At, B1); PG8_BAR; PG8_SCHED;
            PG8_LDA(At, 1, 1); PG8_STAGEB(PG8_SB(1, 0), b3); PG8_STAGEB(PG8_SB(1, 1), b3 + hstep); PG8_STAGE2(PG8_SA(1, 0), a3, w00, w01);
            PG8_WAIT_V(8); PG8_WAIT_L(0); PG8_BAR; PG8_MM(1, 0, At, B0); PG8_MM(1, 1, At, B1); PG8_BAR; PG8_SCHED;
        }
        if constexpr (ALIGN_EPI) { if (wr == 0) PG8_BAR; }
        if constexpr (FP8) asm volatile("s_nop 15\n\ts_nop 15" ::: "memory");
        E(acc, cur, wr, wc, fr, fq);
        if (!has_next) break;
#pragma unroll
        for (int a = 0; a < 2; ++a)
#pragma unroll
            for (int b = 0; b < 2; ++b)
#pragma unroll
                for (int m = 0; m < 4; ++m)
#pragma unroll
                    for (int n = 0; n < 2; ++n) acc[a][b][m][n] = (f32x4){0.f, 0.f, 0.f, 0.f};
        cur = nxt; cA = nA; cB = nB; ++ui;
        if constexpr (!Sched::UNIFORM_AOFF) { vc[0][0] = vn[0][0]; vc[0][1] = vn[0][1]; vc[1][0] = vn[1][0]; vc[1][1] = vn[1][1]; }
        if constexpr (ALIGN_EPI) { if (wr == 1) PG8_BAR; }
    }
    PG8_WAIT_V(0);
    if constexpr (!ALIGN_EPI) { if (wr == 0) PG8_BAR; }
    PG8_BAR;
#undef PG8_SA
#undef PG8_SB
#undef PG8_STAGE2
#undef PG8_STAGEB
#undef PG8_LDA
#undef PG8_LDB
#undef PG8_MMA
#undef PG8_MMA8
#undef PG8_MM
#undef PG8_WAIT_V
#undef PG8_WAIT_L
#undef PG8_BAR
#undef PG8_SCHED
}
}
#define GAS __attribute__((address_space(1)))
#define LAS __attribute__((address_space(3)))
typedef unsigned short bf16;
typedef unsigned v4u __attribute__((ext_vector_type(4)));
typedef float f32x4 __attribute__((ext_vector_type(4)));
typedef short bf16x8 __attribute__((ext_vector_type(8)));
typedef GAS unsigned gu32;
typedef GAS unsigned long long gu64;
#define RLX_AGENT __ATOMIC_RELAXED, __HIP_MEMORY_SCOPE_AGENT
#define LDS_WAIT() asm volatile("s_waitcnt lgkmcnt(0)" ::: "memory")
#define VM_WAIT() asm volatile("s_waitcnt vmcnt(0)" ::: "memory")
__device__ __forceinline__ unsigned long long rt() { return __builtin_amdgcn_s_memrealtime(); }
__device__ __forceinline__ unsigned f2bf(float f) { unsigned u = __builtin_bit_cast(unsigned, f); return (u + 0x7fffu + ((u >> 16) & 1u)) >> 16; }
__device__ __forceinline__ unsigned pk2(float lo, float hi) { return f2bf(lo) | (f2bf(hi) << 16); }

#define XB_TMO      128
#define XB_XCNT(j)  (256  + 64 * (j))
#define XB_XSUB(j)  (1280 + 64 * (j))
#define XB_XGEN(j)  (2304 + 64 * (j))
#define XB_TOP      3328
#define XB_TOPGEN   3392
#define XCD_BAR_WORDS 3456
#define XB_SPIN_CAP (1u << 18)

__device__ __forceinline__ unsigned xb_ld(unsigned* p)              { return __hip_atomic_load(p, __ATOMIC_RELAXED, __HIP_MEMORY_SCOPE_AGENT); }
__device__ __forceinline__ unsigned xb_add(unsigned* p, unsigned v) { return __hip_atomic_fetch_add(p, v, __ATOMIC_RELAXED, __HIP_MEMORY_SCOPE_AGENT); }
__device__ __forceinline__ unsigned xb_xcc_id() { return (unsigned)__builtin_amdgcn_s_getreg((3 << 11) | 20) & 0xFu; }
#define XB_SPIN(cond, bar) do { unsigned _sp = 0; while (cond) { __builtin_amdgcn_s_sleep(1); \
    if ((++_sp & 255u) == 0u) { if (xb_ld(&(bar)[XB_TMO])) break; if (_sp > XB_SPIN_CAP) { atomicAdd(&(bar)[XB_TMO], 1u); break; } } } } while (0)

struct XcdBarrier {
    unsigned* bar; unsigned x;
    volatile LAS unsigned* st;
};

__device__ __forceinline__ XcdBarrier xcd_barrier_post(unsigned* bar, volatile LAS unsigned* st) {
    XcdBarrier b; b.bar = bar; b.x = xb_xcc_id(); b.st = st;
    if (threadIdx.x == 0) (void)xb_add(&bar[XB_XCNT(b.x)], 1u);
    return b;
}
__device__ __forceinline__ void xcd_barrier_complete(unsigned* bar, unsigned x, unsigned& nloc, unsigned& nx) {
    const unsigned G = gridDim.x * gridDim.y * gridDim.z;
    unsigned sum, cnt, mine, sp = 0u;
    for (;;) {
        sum = 0u; cnt = 0u; mine = 0u;
#pragma unroll
        for (unsigned j = 0; j < 16; ++j) { const unsigned c = xb_ld(&bar[XB_XCNT(j)]); sum += c; cnt += (c > 0u) ? 1u : 0u; mine = (j == x) ? c : mine; }
        if (sum == G) break;
        __builtin_amdgcn_s_sleep(1);
        if ((++sp & 255u) == 0u) { if (xb_ld(&bar[XB_TMO])) break; if (sp > XB_SPIN_CAP) { atomicAdd(&bar[XB_TMO], 1u); break; } }
    }
    nloc = mine > 0u ? mine : 1u; nx = cnt > 0u ? cnt : 1u;
}

__device__ __forceinline__ void xcd_barrier(const XcdBarrier& b) {
    asm volatile("s_waitcnt vmcnt(0)" ::: "memory");
    __syncthreads();
    if (threadIdx.x == 0) {
        unsigned* bar = b.bar;
        __builtin_amdgcn_s_waitcnt(0);
        unsigned nloc = b.st[0], nx = b.st[1];
        if (nloc == 0u) { xcd_barrier_complete(bar, b.x, nloc, nx); b.st[0] = nloc; b.st[1] = nx; }
        const unsigned old = xb_add(&bar[XB_XSUB(b.x)], 1u);
        const unsigned gen = old / nloc;
        if (old + 1u == (gen + 1u) * nloc) {
            __builtin_amdgcn_fence(__ATOMIC_RELEASE, "agent");
            asm volatile("s_waitcnt vmcnt(0)" ::: "memory");
            const unsigned og = xb_add(&bar[XB_TOP], 1u);
            const unsigned tg = og / nx;
            if (og + 1u == (tg + 1u) * nx) xb_add(&bar[XB_TOPGEN], 1u);
            else XB_SPIN(xb_ld(&bar[XB_TOPGEN]) == tg, bar);
            __builtin_amdgcn_fence(__ATOMIC_ACQUIRE, "agent");
            xb_add(&bar[XB_XGEN(b.x)], 1u);
            asm volatile("s_waitcnt vmcnt(0)" ::: "memory");
        } else {
            XB_SPIN(xb_ld(&bar[XB_XGEN(b.x)]) == gen, bar);
            __builtin_amdgcn_fence(__ATOMIC_ACQUIRE, "agent");
            asm volatile("s_waitcnt vmcnt(0)" ::: "memory");
        }
    }
    __syncthreads();
}


constexpr int NWAVES = 8;
constexpr int D = 1024, NB = 8, SEQ = 2048, NMETA = 16, L = SEQ + NMETA, T = NB * L;
constexpr int LPAD = 2112, NPADR = 48, MP = NB * LPAD;
constexpr int MR = NB * SEQ;
constexpr int DIN = 3584, NE = 32, TOPK = 4;
constexpr float LN_EPS = 1e-5f, RMS_EPS = 1e-5f;
constexpr float ALPHA = 1.189207115002721f;
constexpr float LAM_INIT = 0.2f;
constexpr bool FP8_GU = true, FP8_DN = true;
constexpr float W_GU_SCALE = 32.f, W_DN_SCALE = 64.f;
constexpr bool FP8_YE = true;
constexpr float YE_SCALE = 8.f;

constexpr size_t MiB = 1u << 20;
constexpr size_t WS_CTL = 0, CTL_ZERO_BYTES = 1 * MiB;
constexpr size_t WS_WIN = 1 * MiB;
constexpr size_t WS_WOUT = 8 * MiB;
constexpr size_t WS_ROPE = 10 * MiB;
constexpr size_t WS_LB = 11 * MiB;
constexpr size_t WS_STATS = 11 * MiB + 65536;
constexpr size_t WS_WGU = 12 * MiB;
constexpr size_t WS_WDN = 140 * MiB;
constexpr size_t WS_H0B = 204 * MiB;
constexpr size_t SZ_P512 = (size_t)MP * 512 * 2;
constexpr size_t WS_QA = 237 * MiB, WS_KA = WS_QA + SZ_P512, WS_VA = WS_KA + SZ_P512, WS_QB = WS_VA + SZ_P512, WS_VB = WS_QB + SZ_P512, WS_GB = WS_VB + SZ_P512;
constexpr size_t WS_LF = 336 * MiB;
constexpr size_t WS_Y = 369 * MiB;
static_assert(WS_GB + SZ_P512 <= WS_LF && WS_LF + (size_t)MP * 512 * 4 <= WS_Y, "ws map");
constexpr size_t WS_WRT = 11 * MiB + 262144;
constexpr size_t WS_PRE1 = 402 * MiB;
constexpr size_t WS_H1B = 466 * MiB;
constexpr size_t WS_ST1 = 498 * MiB;
constexpr size_t WS_GATES = WS_ST1 + 262144;
constexpr size_t WS_TSLOT = WS_GATES + 262144;
constexpr size_t WS_LIST = 499 * MiB;
constexpr size_t WS_ACT = 502 * MiB;
constexpr size_t WS_YE = 646 * MiB;
constexpr size_t WS_UH = 790 * MiB;
constexpr size_t WS_SP = 856 * MiB;
constexpr size_t WS_EL = 889 * MiB;
constexpr int CW_BAR = 4096;
constexpr int CW_CNT = 16384;
constexpr int CW_GRP = 12288;
constexpr bool MOE_SPLIT_SEAM = true;
constexpr int CW_JOB = 8192;
constexpr int CW_HGA = 32768, CW_HGS = 32768 + 64 * 32;

constexpr int RING_OFF = 0, RING_BYTES = 131072;
constexpr int LDSCTL_OFF = RING_BYTES, MISC_OFF = LDSCTL_OFF + 320;
constexpr int LDS_BYTES = 147456;
constexpr int TPRE_OFF = LDSCTL_OFF + 512, LCNT_OFF = LDSCTL_OFF + 768, GBASE_OFF = LDSCTL_OFF + 1024, SEL_OFF = LDSCTL_OFF + 2048;

struct Frame {
    LAS unsigned char* lds;
    volatile LAS unsigned* MISC;
    gu32* ctl;
    int tid, lane, wave, vcu, G;
};
__device__ __forceinline__ float wave_sum(float v) {
#pragma unroll
    for (int o = 1; o < 64; o <<= 1) v += __shfl_xor(v, o);
    return v;
}
template <bool ROPEPERM>
__device__ __forceinline__ void p0_transpose_item(const float* W, int K, int N, bf16* WT, LAS float* scr, int item, int lane) {
    const int nblk = N / 32, kb = item / nblk, nb = item % nblk, k0 = 64 * kb, n0 = 32 * nb;
    f32x4 tv[8];
    const int r = lane >> 3, c4 = lane & 7;
#pragma unroll
    for (int i = 0; i < 8; ++i) tv[i] = *(const GAS f32x4*)(W + (size_t)(k0 + 8 * r + i) * N + n0 + c4 * 4);
#pragma unroll
    for (int e = 0; e < 4; ++e) {
        v4u o; o.x = pk2(tv[0][e], tv[1][e]); o.y = pk2(tv[2][e], tv[3][e]); o.z = pk2(tv[4][e], tv[5][e]); o.w = pk2(tv[6][e], tv[7][e]);
        int nd = n0 + 4 * c4 + e;
        if (ROPEPERM && nd < 1024) { const int d = nd & 63; nd = (nd & ~63) | ((d & 31) << 1) | (d >> 5); }
        *(GAS v4u*)(WT + (size_t)nd * K + k0 + 8 * r) = o; }
}
constexpr int CONV_JOBS = (NE * (D / 64) * (2 * D / 32) + NE * (D / 64) * (D / 32)) / 64;
constexpr int P1_SHORT0 = 156, CONV_P1 = 100, CONV_PER_X = 84;
template <int N> __device__ __forceinline__ void conv_load(f32x4 (&tv)[8], const float* W, int idx, int lane) {
    constexpr int nblk = N / 32; const int e = idx / (16 * nblk), rem = idx % (16 * nblk), k0 = 64 * (rem / nblk), n0 = 32 * (rem % nblk);
    const float* src = W + (size_t)e * D * N + (size_t)(k0 + 8 * (lane >> 3)) * N + n0 + (lane & 7) * 4;
#pragma unroll
    for (int i = 0; i < 8; ++i) tv[i] = *(const GAS f32x4*)(src + (size_t)i * N);
}
template <int N, bool F8> __device__ __forceinline__ void conv_finish(const f32x4 (&tv)[8], bf16* WT, int idx, LAS float* scr, int lane, float scale) {
    constexpr int nblk = N / 32; const int e = idx / (16 * nblk), rem = idx % (16 * nblk), k0 = 64 * (rem / nblk), n0 = 32 * (rem % nblk);
    const int r = lane >> 3, c4 = lane & 7;
#pragma unroll
    for (int q = 0; q < 4; ++q) { const int n = n0 + 4 * c4 + q;
        if constexpr (F8) {
            pg8::u32x2 o; o.x = pg8::pk4_fp8(tv[0][q] * scale, tv[1][q] * scale, tv[2][q] * scale, tv[3][q] * scale); o.y = pg8::pk4_fp8(tv[4][q] * scale, tv[5][q] * scale, tv[6][q] * scale, tv[7][q] * scale);
            *(GAS pg8::u32x2*)((unsigned char*)WT + (size_t)e * N * D + (size_t)n * D + k0 + 8 * r) = o;
        } else {
            v4u o; o.x = pk2(tv[0][q], tv[1][q]); o.y = pk2(tv[2][q], tv[3][q]); o.z = pk2(tv[4][q], tv[5][q]); o.w = pk2(tv[6][q], tv[7][q]);
            *(GAS v4u*)(WT + (size_t)e * N * D + (size_t)n * D + k0 + 8 * r) = o; }
    }
}
template <int N, bool F8> __device__ __forceinline__ void conv_items(const float* W, bf16* WT, int idx0, LAS float* scr, int lane, float scale) {
    f32x4 ta[8], tb[8], tc[8];
    conv_load<N>(ta, W, idx0, lane);
    conv_load<N>(tb, W, idx0 + 8, lane);
    conv_load<N>(tc, W, idx0 + 16, lane);  conv_finish<N, F8>(ta, WT, idx0, scr, lane, scale);
    conv_load<N>(ta, W, idx0 + 24, lane);  conv_finish<N, F8>(tb, WT, idx0 + 8, scr, lane, scale);
    conv_load<N>(tb, W, idx0 + 32, lane);  conv_finish<N, F8>(tc, WT, idx0 + 16, scr, lane, scale);
    conv_load<N>(tc, W, idx0 + 40, lane);  conv_finish<N, F8>(ta, WT, idx0 + 24, scr, lane, scale);
    conv_load<N>(ta, W, idx0 + 48, lane);  conv_finish<N, F8>(tb, WT, idx0 + 32, scr, lane, scale);
    conv_load<N>(tb, W, idx0 + 56, lane);  conv_finish<N, F8>(tc, WT, idx0 + 40, scr, lane, scale);
    conv_finish<N, F8>(ta, WT, idx0 + 48, scr, lane, scale);
    conv_finish<N, F8>(tb, WT, idx0 + 56, scr, lane, scale);
}
__device__ __forceinline__ void conv_job(const Frame& F, int v, const float* w_gu, const float* w_dn, unsigned char* ws) {
    LAS float* scr = (LAS float*)(F.lds + RING_OFF + F.wave * 16384);
    int lane = F.lane; asm volatile("" : "+v"(lane));
    if (v < 512) conv_items<2 * D, FP8_GU>(w_gu, (bf16*)(ws + WS_WGU), v * 64 + F.wave, scr, lane, W_GU_SCALE);
    else conv_items<D, FP8_DN>(w_dn, (bf16*)(ws + WS_WDN), (v - 512) * 64 + F.wave, scr, lane, W_DN_SCALE);
}
struct P0Args { const float *x, *meta, *g, *b, *w_in, *w_out, *w_gu, *w_dn, *lbt, *w_router; };
__device__ __forceinline__ void p0_prologue(Frame& F, const P0Args& a, unsigned char* ws) {
    LAS float* scr = (LAS float*)(F.lds + RING_OFF + F.wave * 16384);
    const int gw = F.vcu * NWAVES + F.wave, NGW = F.G * NWAVES;
    constexpr int I_IN = (D / 64) * (DIN / 32), I_OUT = (D / 64) * (D / 32);
    constexpr int NITEMS = I_IN + I_OUT;
    bf16* WIN = (bf16*)(ws + WS_WIN); bf16* WOUT = (bf16*)(ws + WS_WOUT);
    for (int it = gw; it < NITEMS; it += NGW) {
        int r = it;
        if (r < I_IN) { p0_transpose_item<true>(a.w_in, D, DIN, WIN, scr, r, F.lane); continue; } r -= I_IN;
        p0_transpose_item<false>(a.w_out, D, D, WOUT, scr, r, F.lane);
    }
    bf16* H0B = (bf16*)(ws + WS_H0B); float* STATS = (float*)(ws + WS_STATS);
    for (int pr = gw; pr < MP; pr += NGW) {
        const int bb = pr / LPAD, t = pr % LPAD;
        GAS unsigned long long* o8 = (GAS unsigned long long*)(H0B + (size_t)pr * D) + F.lane;
        if (t < NPADR) {
#pragma unroll
            for (int j = 0; j < 4; ++j) o8[64 * j] = 0ull;
            continue;
        }
        const float* xrow = (t < 64) ? a.meta + (size_t)(t - NPADR) * D : a.x + ((size_t)bb * SEQ + (t - 64)) * D;
        const GAS f32x4* xr = (const GAS f32x4*)xrow + F.lane;
        f32x4 v[4]; float s = 0.f;
#pragma unroll
        for (int j = 0; j < 4; ++j) { v[j] = xr[64 * j]; s += (v[j].x + v[j].y) + (v[j].z + v[j].w); }
        const float mean = wave_sum(s) * (1.f / D); float s2 = 0.f;
#pragma unroll
        for (int j = 0; j < 4; ++j) { v[j] = v[j] - mean; s2 += (v[j].x * v[j].x + v[j].y * v[j].y) + (v[j].z * v[j].z + v[j].w * v[j].w); }
        const float rstd = 1.f / sqrtf(wave_sum(s2) * (1.f / D) + LN_EPS);
#pragma unroll
        for (int j = 0; j < 4; ++j) {
            const f32x4 gv = ((const GAS f32x4*)a.g)[F.lane + 64 * j], bv = ((const GAS f32x4*)a.b)[F.lane + 64 * j];
            const f32x4 o = v[j] * rstd * gv + bv;
            o8[64 * j] = (unsigned long long)pk2(o.x, o.y) | ((unsigned long long)pk2(o.z, o.w) << 32);
        }
        if (t >= 64 && F.lane == 0) { STATS[((size_t)bb * SEQ + (t - 64)) * 2] = mean; STATS[((size_t)bb * SEQ + (t - 64)) * 2 + 1] = rstd; }
    }
    float* ROPE = (float*)(ws + WS_ROPE); float* LBT = (float*)(ws + WS_LB);
    const int gt = F.vcu * NWAVES * 64 + F.tid, NGT = F.G * NWAVES * 64;
    for (int i = gt; i < LPAD * 32; i += NGT) {
        const int t = i >> 5, j = i & 31; const int pos = t < NPADR ? 0 : t - NPADR;
        const float inv = 1.0f / powf(10000.0f, (float)(2 * j) / 64.0f);
        const float ang = (float)pos * inv;
        ROPE[2 * i] = cosf(ang); ROPE[2 * i + 1] = sinf(ang);
    }
    { unsigned short* WRH = (unsigned short*)(ws + WS_WRT); unsigned short* WRL = WRH + NE * D;
      for (int i = gt; i < NE * D; i += NGT) { const int e = i >> 10, d = i & 1023; const float v = a.w_router[d * NE + e];
          const unsigned h = f2bf(v); WRH[i] = (unsigned short)h; WRL[i] = (unsigned short)f2bf(v - __builtin_bit_cast(float, h << 16)); } }
    for (int i = gt; i < 512; i += NGT) {
        const float t0 = a.lbt[i], t1 = a.lbt[512 + i]; const float mx = fmaxf(t0, t1); const float e0 = expf(t0 - mx), e1 = expf(t1 - mx);
        LBT[i] = e0 / (e0 + e1);
    }
}

namespace att {
typedef short s16x4 __attribute__((ext_vector_type(4)));
typedef short v4i16_t __attribute__((ext_vector_type(4)));
typedef unsigned u32x2 __attribute__((ext_vector_type(2)));
constexpr int ROWB = 288, TILEB = 64 * ROWB;
__device__ __forceinline__ s16x4 vtr(const LAS unsigned char* p) { return __builtin_bit_cast(s16x4, __builtin_amdgcn_ds_read_tr16_b64_v4i16((LAS v4i16_t*)p)); }
__device__ __forceinline__ unsigned cvtpk(float lo, float hi) { unsigned r; asm volatile("v_cvt_pk_bf16_f32 %0, %1, %2" : "=v"(r) : "v"(lo), "v"(hi)); return r; }
#define MFMA16(a, b, c) __builtin_amdgcn_mfma_f32_16x16x32_bf16((a), (b), (c), 0, 0, 0)

__device__ __forceinline__ void attn_tile(const LAS unsigned char* Kb, const LAS unsigned char* Vb, const bf16x8 (&qf)[2][2], f32x4 (&o1)[8], f32x4 (&o2)[8], float& l1, float& l2, bool first, int r16, int quad) {
    const f32x4 z = {0.f, 0.f, 0.f, 0.f};
    const LAS unsigned char* kp = Kb + r16 * ROWB + quad * 16;
    const LAS unsigned char* vp = Vb + (4 * quad + (r16 >> 2)) * ROWB + (r16 & 3) * 8;
    bf16x8 kf[4][4];
#pragma unroll
    for (int kb = 0; kb < 4; ++kb)
#pragma unroll
        for (int t = 0; t < 4; ++t) kf[kb][t] = *(const LAS bf16x8*)(kp + kb * 16 * ROWB + t * 64);
    s16x4 vlo[4][2], vhi[4][2];
#pragma unroll
    for (int db = 0; db < 4; ++db)
#pragma unroll
        for (int s = 0; s < 2; ++s) { vlo[db][s] = vtr(vp + (32 * s) * ROWB + db * 32); vhi[db][s] = vtr(vp + (32 * s + 16) * ROWB + db * 32); }
    __builtin_amdgcn_sched_barrier(0);
    f32x4 s1[4], s2[4];
#pragma unroll
    for (int kb = 0; kb < 4; ++kb) {
        s1[kb] = MFMA16(kf[kb][0], qf[0][0], z); s1[kb] = MFMA16(kf[kb][1], qf[0][1], s1[kb]);
        s2[kb] = MFMA16(kf[kb][2], qf[1][0], z); s2[kb] = MFMA16(kf[kb][3], qf[1][1], s2[kb]);
    }
#pragma unroll
    for (int kb = 0; kb < 4; ++kb)
#pragma unroll
        for (int j = 0; j < 4; ++j) { s1[kb][j] = __builtin_amdgcn_exp2f(s1[kb][j]); s2[kb][j] = __builtin_amdgcn_exp2f(s2[kb][j]); }
    if (first) {
#pragma unroll
        for (int kb = 0; kb < 3; ++kb) { s1[kb] = z; s2[kb] = z; }
    }
#pragma unroll
    for (int kb = 0; kb < 4; ++kb) { l1 += (s1[kb][0] + s1[kb][1]) + (s1[kb][2] + s1[kb][3]); l2 += (s2[kb][0] + s2[kb][1]) + (s2[kb][2] + s2[kb][3]); }
    bf16x8 p1[2], p2[2];
#pragma unroll
    for (int s = 0; s < 2; ++s) {
        v4u a, b;
        a.x = cvtpk(s1[2 * s][0], s1[2 * s][1]); a.y = cvtpk(s1[2 * s][2], s1[2 * s][3]); a.z = cvtpk(s1[2 * s + 1][0], s1[2 * s + 1][1]); a.w = cvtpk(s1[2 * s + 1][2], s1[2 * s + 1][3]);
        b.x = cvtpk(s2[2 * s][0], s2[2 * s][1]); b.y = cvtpk(s2[2 * s][2], s2[2 * s][3]); b.z = cvtpk(s2[2 * s + 1][0], s2[2 * s + 1][1]); b.w = cvtpk(s2[2 * s + 1][2], s2[2 * s + 1][3]);
        p1[s] = __builtin_bit_cast(bf16x8, a); p2[s] = __builtin_bit_cast(bf16x8, b);
    }
    __builtin_amdgcn_sched_barrier(0);
    s16x4 wlo[4][2], whi[4][2];
#pragma unroll
    for (int db = 0; db < 4; ++db)
#pragma unroll
        for (int s = 0; s < 2; ++s) { wlo[db][s] = vtr(vp + (32 * s) * ROWB + (db + 4) * 32); whi[db][s] = vtr(vp + (32 * s + 16) * ROWB + (db + 4) * 32); }
    __builtin_amdgcn_sched_barrier(0);
#pragma unroll
    for (int db = 0; db < 4; ++db)
#pragma unroll
        for (int s = 0; s < 2; ++s) { const bf16x8 vf = __builtin_shufflevector(vlo[db][s], vhi[db][s], 0, 1, 2, 3, 4, 5, 6, 7); o1[db] = MFMA16(vf, p1[s], o1[db]); o2[db] = MFMA16(vf, p2[s], o2[db]); }
    __builtin_amdgcn_sched_barrier(0);
#pragma unroll
    for (int db = 0; db < 4; ++db)
#pragma unroll
        for (int s = 0; s < 2; ++s) { const bf16x8 vf = __builtin_shufflevector(wlo[db][s], whi[db][s], 0, 1, 2, 3, 4, 5, 6, 7); o1[db + 4] = MFMA16(vf, p1[s], o1[db + 4]); o2[db + 4] = MFMA16(vf, p2[s], o2[db + 4]); }
}

__device__ __forceinline__ void attn_unit(const Frame& F, int b, int h, int i, const bf16* QA, const bf16* KA, const bf16* VA, bf16* Y, float lam, const float* subg) {
    int tid = F.tid; asm volatile("" : "+v"(tid));
    const int lane = tid & 63, w = F.wave, r16 = lane & 15, quad = lane >> 4;
    const size_t rowbase = (size_t)b * LPAD;
    const int qrow = 64 + 128 * i + 16 * w + r16;
    bf16x8 qf[2][2];
#pragma unroll
    for (int sub = 0; sub < 2; ++sub)
#pragma unroll
        for (int s = 0; s < 2; ++s) qf[sub][s] = *(const GAS bf16x8*)(QA + (rowbase + qrow) * 512 + h * 128 + sub * 64 + s * 32 + quad * 8);
    f32x4 o1[8], o2[8];
#pragma unroll
    for (int db = 0; db < 8; ++db) { o1[db] = (f32x4){0.f, 0.f, 0.f, 0.f}; o2[db] = (f32x4){0.f, 0.f, 0.f, 0.f}; }
    float l1 = 0.f, l2 = 0.f;
    const int nt = 2 * i + 3, mytiles = 2 * i + 2 + (w >> 2);
    LAS unsigned char* lds = F.lds + RING_OFF;
    const int srow0 = tid >> 4, sch = tid & 15;
    const bf16* kg = KA + (rowbase + srow0) * 512 + h * 128 + sch * 8;
    const bf16* vg = VA + (rowbase + srow0) * 512 + h * 128 + sch * 8;
    const int soff = srow0 * ROWB + sch * 16;
    v4u kr0, kr1, vr0, vr1;
    kr0 = *(const GAS v4u*)(kg); kr1 = *(const GAS v4u*)(kg + 32 * 512); vr0 = *(const GAS v4u*)(vg); vr1 = *(const GAS v4u*)(vg + 32 * 512);
    *(LAS v4u*)(lds + soff) = kr0; *(LAS v4u*)(lds + soff + 32 * ROWB) = kr1; *(LAS v4u*)(lds + TILEB + soff) = vr0; *(LAS v4u*)(lds + TILEB + soff + 32 * ROWB) = vr1;
    __syncthreads();
    for (int kt = 0; kt < nt; ++kt) {
        const bool more = kt + 1 < nt;
        if (more) { const size_t go = (size_t)(kt + 1) * 64 * 512;
            kr0 = *(const GAS v4u*)(kg + go); kr1 = *(const GAS v4u*)(kg + go + 32 * 512); vr0 = *(const GAS v4u*)(vg + go); vr1 = *(const GAS v4u*)(vg + go + 32 * 512); }
        const LAS unsigned char* Kb = lds + (kt & 1) * 2 * TILEB;
        if (kt < mytiles) attn_tile(Kb, Kb + TILEB, qf, o1, o2, l1, l2, kt == 0, r16, quad);
        if (more) { LAS unsigned char* nb = lds + ((kt + 1) & 1) * 2 * TILEB;
            *(LAS v4u*)(nb + soff) = kr0; *(LAS v4u*)(nb + soff + 32 * ROWB) = kr1; *(LAS v4u*)(nb + TILEB + soff) = vr0; *(LAS v4u*)(nb + TILEB + soff + 32 * ROWB) = vr1; }
        __syncthreads();
    }
    l1 += __shfl_xor(l1, 16); l1 += __shfl_xor(l1, 32); l2 += __shfl_xor(l2, 16); l2 += __shfl_xor(l2, 32);
    const float i1 = 1.0f / l1, i2 = lam / l2;
    float ss = 0.f;
#pragma unroll
    for (int db = 0; db < 8; ++db)
#pragma unroll
        for (int j = 0; j < 4; ++j) { const float o = o1[db][j] * i1 - o2[db][j] * i2; o1[db][j] = o; ss += o * o; }
    ss += __shfl_xor(ss, 16); ss += __shfl_xor(ss, 32);
    const float rn = (1.0f - LAM_INIT) / sqrtf(ss * (1.0f / 128.0f) + RMS_EPS);
    bf16* yo = Y + (rowbase + qrow) * 1024 + h * 128 + 4 * quad;
#pragma unroll
    for (int db = 0; db < 8; ++db) {
        const f32x4 g4 = *(const GAS f32x4*)(subg + db * 16 + 4 * quad);
        u32x2 wv; wv.x = cvtpk(o1[db][0] * rn * g4[0], o1[db][1] * rn * g4[1]); wv.y = cvtpk(o1[db][2] * rn * g4[2], o1[db][3] * rn * g4[3]);
        *(GAS u32x2*)(yo + db * 16) = wv;
    }
}
}

namespace hg {
using att::s16x4; using att::u32x2; using att::vtr; using att::cvtpk;
typedef float f32x2 __attribute__((ext_vector_type(2)));
constexpr int ROWB = 288, KTROW = 160, NUNIT = 32 * 33;
constexpr int QT = 0, KT = 18432, VT = 36864, KTT = 55296, Q2 = 55296, SH = 75776, TOT = 112640, EV = 120832, RMSP = 122368;
static_assert(RMSP + 1024 <= RING_BYTES, "hgrn LDS map");
__device__ __forceinline__ int dkperm(int dk) { const int d = dk & 31; return (dk & ~31) | (((d >> 2) & 3) << 3) | ((d >> 4) << 2) | (d & 3); }

__device__ __forceinline__ void hg_arrive(const Frame& F, gu32* ctr) {
    asm volatile("s_waitcnt vmcnt(0)" ::: "memory");
    __syncthreads();
    if (F.tid == 0) __hip_atomic_fetch_add(ctr, 1u, RLX_AGENT);
}
__device__ __forceinline__ void hg_wait(const Frame& F, gu32* ctr, unsigned target) {
    if (F.tid == 0) { unsigned sp = 0; while (__hip_atomic_load(ctr, RLX_AGENT) < target && ++sp < (1u << 22)) __builtin_amdgcn_s_sleep(2); }
    __syncthreads();
}
__device__ __forceinline__ void hgA_unit(const Frame& F0, int u, int par, const float* LF, const bf16* VB, bf16* UH, float* EL, gu32* ctr) {
    Frame F = F0; asm volatile("" : "+v"(F.tid)); F.lane = F.tid & 63;
    const int tid = F.tid, lane = F.lane, w = F.wave, r16 = lane & 15, quad = lane >> 4;
    LAS unsigned char* lds = F.lds + RING_OFF;
    const int bh = u / 33, c = u - bh * 33;
    const size_t r0 = (size_t)(bh >> 2) * LPAD + (size_t)c * 64; const int colh = (bh & 3) * 128;
    const f32x4 z4 = {0.f, 0.f, 0.f, 0.f};
    f32x2 lf[8]; v4u vv0, vv1;
    const int srow0 = tid >> 4, sch = tid & 15;
#pragma unroll
    for (int e = 0; e < 8; ++e) lf[e] = *(const GAS f32x2*)(LF + (r0 + 8 * w + e) * 512 + colh + 2 * lane);
    vv0 = *(const GAS v4u*)(VB + (r0 + srow0) * 512 + colh + sch * 8); vv1 = *(const GAS v4u*)(VB + (r0 + srow0 + 32) * 512 + colh + sch * 8);
    LAS float* tot = (LAS float*)(lds + TOT + par * 4096);
    f32x2 bc[8]; f32x2 run = {0.f, 0.f};
#pragma unroll
    for (int e = 0; e < 8; ++e) { if (c == 0 && 8 * w + e < NPADR) lf[e] = (f32x2){0.f, 0.f}; run = run + lf[e]; bc[e] = run; }
    *(LAS f32x2*)(tot + w * 128 + 2 * lane) = run;
    __syncthreads();
    f32x2 off = {0.f, 0.f}, bmid = {0.f, 0.f}, blast = {0.f, 0.f};
#pragma unroll
    for (int ww = 0; ww < 8; ++ww) { const f32x2 t = *(const LAS f32x2*)(tot + ww * 128 + 2 * lane); if (ww < w) off = off + t; if (ww < 4) bmid = bmid + t; blast = blast + t; }
    unsigned kk0[8], kk1[8];
#pragma unroll
    for (int e = 0; e < 8; ++e) {
        const f32x2 bb = off + bc[e] - bmid;
        const float e0 = __builtin_amdgcn_exp2f(fminf(fmaxf(bb.x, -120.f), 120.f)), e1 = __builtin_amdgcn_exp2f(fminf(fmaxf(bb.y, -120.f), 120.f));
        const float k0 = (1.0f - __builtin_amdgcn_exp2f(lf[e].x)) * __builtin_amdgcn_rcpf(e0), k1 = (1.0f - __builtin_amdgcn_exp2f(lf[e].y)) * __builtin_amdgcn_rcpf(e1);
        const unsigned kp = cvtpk(k0, k1);
        kk0[e] = kp & 0xffffu; kk1[e] = kp >> 16;
    }
    {
        const int w4 = w & 3, sp = w >> 2;
        const int pos0 = ((2 * w4) & 3) * 8 + (w4 >> 1) * 4, pos1 = ((2 * w4 + 1) & 3) * 8 + (w4 >> 1) * 4;
        LAS unsigned char* q0 = lds + KTT + (2 * lane) * KTROW + sp * 64, *q1 = q0 + KTROW;
        u32x2 a; a.x = kk0[0] | (kk0[1] << 16); a.y = kk0[2] | (kk0[3] << 16); *(LAS u32x2*)(q0 + pos0 * 2) = a;
        a.x = kk0[4] | (kk0[5] << 16); a.y = kk0[6] | (kk0[7] << 16); *(LAS u32x2*)(q0 + pos1 * 2) = a;
        a.x = kk1[0] | (kk1[1] << 16); a.y = kk1[2] | (kk1[3] << 16); *(LAS u32x2*)(q1 + pos0 * 2) = a;
        a.x = kk1[4] | (kk1[5] << 16); a.y = kk1[6] | (kk1[7] << 16); *(LAS u32x2*)(q1 + pos1 * 2) = a;
    }
    *(LAS v4u*)(lds + VT + srow0 * ROWB + sch * 16) = vv0; *(LAS v4u*)(lds + VT + (srow0 + 32) * ROWB + sch * 16) = vv1;
    if (w == 0) {
        LAS float* ev = (LAS float*)(lds + EV);
        *(LAS f32x2*)(ev + 2 * lane) = (f32x2){__builtin_amdgcn_exp2f(fmaxf(blast.x - bmid.x, -120.f)), __builtin_amdgcn_exp2f(fmaxf(blast.y - bmid.y, -120.f))};
        __hip_atomic_store((gu64*)(EL + (size_t)u * 128 + 2 * lane), (unsigned long long)__float_as_uint(__builtin_amdgcn_exp2f(fmaxf(blast.x, -120.f))) | ((unsigned long long)__float_as_uint(__builtin_amdgcn_exp2f(fmaxf(blast.y, -120.f))) << 32), RLX_AGENT);
    }
    __syncthreads();
    const LAS unsigned char* vpw = lds + VT + (4 * quad + (r16 >> 2)) * ROWB + (r16 & 3) * 8 + w * 32;
    const s16x4 lo0 = vtr(vpw), hi0 = vtr(vpw + 16 * ROWB), lo1 = vtr(vpw + 32 * ROWB), hi1 = vtr(vpw + 48 * ROWB);
    const bf16x8 v0 = __builtin_shufflevector(lo0, hi0, 0, 1, 2, 3, 4, 5, 6, 7), v1 = __builtin_shufflevector(lo1, hi1, 0, 1, 2, 3, 4, 5, 6, 7);
    const LAS unsigned char* ktp = lds + KTT + r16 * KTROW + quad * 16;
    const LAS float* ev = (const LAS float*)(lds + EV);
    bf16x8 tf[8][2]; float elm[8];
#pragma unroll
    for (int nb = 0; nb < 8; ++nb) { tf[nb][0] = *(const LAS bf16x8*)(ktp + nb * 16 * KTROW); tf[nb][1] = *(const LAS bf16x8*)(ktp + nb * 16 * KTROW + 64); elm[nb] = ev[nb * 16 + r16]; }
    gu64* uo = (gu64*)(UH + ((size_t)u * 8 + w) * 2048) + lane;
#pragma unroll
    for (int nb = 0; nb < 8; ++nb) { f32x4 uu = MFMA16(v0, tf[nb][0], z4); uu = MFMA16(v1, tf[nb][1], uu); uu = uu * elm[nb];
        __hip_atomic_store(uo + nb * 64, (unsigned long long)cvtpk(uu[0], uu[1]) | ((unsigned long long)cvtpk(uu[2], uu[3]) << 32), RLX_AGENT); }
    hg_arrive(F, ctr);
}

__device__ __forceinline__ void hg_scan_job(int job, int lane, const bf16* UH, const float* EL, bf16* SP) {
    const int bh = job >> 6, w = (job >> 3) & 7, nb = job & 7, r16 = lane & 15;
    f32x4 S = {0.f, 0.f, 0.f, 0.f};
    const size_t ubase = (size_t)bh * 33;
    unsigned long long ub[33]; unsigned el[33];
#pragma unroll
    for (int c = 0; c < 33; ++c) {
        ub[c] = __hip_atomic_load((gu64*)(UH + ((ubase + c) * 8 + w) * 2048 + nb * 256 + lane * 4), RLX_AGENT);
        el[c] = __hip_atomic_load((gu32*)(EL + (ubase + c) * 128 + nb * 16 + r16), RLX_AGENT);
    }
#pragma unroll
    for (int c = 0; c < 33; ++c) {
        const f32x4 uh = {__uint_as_float((unsigned)ub[c] << 16), __uint_as_float((unsigned)ub[c] & 0xffff0000u), __uint_as_float((unsigned)(ub[c] >> 32) << 16), __uint_as_float((unsigned)(ub[c] >> 32) & 0xffff0000u)};
        __hip_atomic_store((gu64*)(SP + ((ubase + c) * 8 + w) * 2048 + nb * 256 + lane * 4), (unsigned long long)cvtpk(S[0], S[1]) | ((unsigned long long)cvtpk(S[2], S[3]) << 32), RLX_AGENT);
        S = S * __uint_as_float(el[c]) + uh;
    }
}

__device__ __forceinline__ void hgC_unit(const Frame& F0, int u, int par, const bf16* QB, const float* LF, const bf16* VB, const bf16* GB, const bf16* SP, bf16* Y, const float* norm_g, gu32* ctr) {
    Frame F = F0; asm volatile("" : "+v"(F.tid)); F.lane = F.tid & 63;
    const int tid = F.tid, lane = F.lane, w = F.wave, r16 = lane & 15, quad = lane >> 4;
    LAS unsigned char* lds = F.lds + RING_OFF;
    const int bh = u / 33, c = u - bh * 33;
    const size_t r0 = (size_t)(bh >> 2) * LPAD + (size_t)c * 64; const int colh = (bh & 3) * 128;
    const f32x4 z4 = {0.f, 0.f, 0.f, 0.f};
    const int srow0 = tid >> 4, sch = tid & 15;
    const int tb = w & 3, dh = w >> 2;
    f32x2 lf[8]; unsigned qb[8]; v4u vv0, vv1; u32x2 sp8[8], gbv[4];
#pragma unroll
    for (int e = 0; e < 8; ++e) { const size_t o = (r0 + 8 * w + e) * 512 + colh + 2 * lane; lf[e] = *(const GAS f32x2*)(LF + o); qb[e] = *(const GAS unsigned*)(QB + o); }
    vv0 = *(const GAS v4u*)(VB + (r0 + srow0) * 512 + colh + sch * 8); vv1 = *(const GAS v4u*)(VB + (r0 + srow0 + 32) * 512 + colh + sch * 8);
    hg_wait(F, ctr, 8u);
    { gu64* sp = (gu64*)(SP + ((size_t)u * 8 + w) * 2048) + lane;
#pragma unroll
      for (int nb = 0; nb < 8; ++nb) { const unsigned long long a0 = __hip_atomic_load(sp + nb * 64, RLX_AGENT); sp8[nb] = (u32x2){(unsigned)a0, (unsigned)(a0 >> 32)}; } }
    const size_t orow = r0 + tb * 16 + r16;
#pragma unroll
    for (int d = 0; d < 4; ++d) gbv[d] = *(const GAS u32x2*)(GB + orow * 512 + colh + (dh * 4 + d) * 16 + 4 * quad);
    LAS float* tot = (LAS float*)(lds + TOT + par * 4096);
    f32x2 bc[8]; f32x2 run = {0.f, 0.f};
#pragma unroll
    for (int e = 0; e < 8; ++e) { if (c == 0 && 8 * w + e < NPADR) lf[e] = (f32x2){0.f, 0.f}; run = run + lf[e]; bc[e] = run; }
    *(LAS f32x2*)(tot + w * 128 + 2 * lane) = run;
    __syncthreads();
    f32x2 off = {0.f, 0.f}, bmid = {0.f, 0.f};
#pragma unroll
    for (int ww = 0; ww < 8; ++ww) { const f32x2 t = *(const LAS f32x2*)(tot + ww * 128 + 2 * lane); if (ww < w) off = off + t; if (ww < 4) bmid = bmid + t; }
    const f32x2 em = {__builtin_amdgcn_exp2f(fmaxf(bmid.x, -120.f)), __builtin_amdgcn_exp2f(fmaxf(bmid.y, -120.f))};
    const int pcol = dkperm(2 * lane) * 2;
#pragma unroll
    for (int e = 0; e < 8; ++e) {
        const f32x2 bb = off + bc[e] - bmid;
        const float e0 = __builtin_amdgcn_exp2f(fminf(fmaxf(bb.x, -120.f), 120.f)), e1 = __builtin_amdgcn_exp2f(fminf(fmaxf(bb.y, -120.f), 120.f));
        const float q0 = __uint_as_float(qb[e] << 16) * e0, q1 = __uint_as_float(qb[e] & 0xffff0000u) * e1;
        const float k0 = (1.0f - __builtin_amdgcn_exp2f(lf[e].x)) * __builtin_amdgcn_rcpf(e0), k1 = (1.0f - __builtin_amdgcn_exp2f(lf[e].y)) * __builtin_amdgcn_rcpf(e1);
        *(LAS unsigned*)(lds + QT + (8 * w + e) * ROWB + pcol) = cvtpk(q0, q1);
        *(LAS unsigned*)(lds + Q2 + (8 * w + e) * ROWB + pcol) = cvtpk(q0 * em.x, q1 * em.y);
        *(LAS unsigned*)(lds + KT + (8 * w + e) * ROWB + pcol) = cvtpk(k0, k1);
    }
    *(LAS v4u*)(lds + VT + srow0 * ROWB + sch * 16) = vv0; *(LAS v4u*)(lds + VT + (srow0 + 32) * ROWB + sch * 16) = vv1;
#pragma unroll
    for (int nb = 0; nb < 8; ++nb) {
        *(LAS u32x2*)(lds + SH + (nb * 16 + r16) * ROWB + (16 * w + 4 * quad) * 2) = sp8[nb];
    }
    __syncthreads();
    const int troff = (4 * quad + (r16 >> 2)) * ROWB + (r16 & 3) * 8;
    const LAS unsigned char* vp = lds + VT + troff;
    const LAS unsigned char* shp = lds + SH + troff + dh * 128;
    const LAS unsigned char* qp = lds + QT + (tb * 16 + r16) * ROWB + quad * 16;
    const LAS unsigned char* q2p = lds + Q2 + (tb * 16 + r16) * ROWB + quad * 16;
    const LAS unsigned char* kp0 = lds + KT + r16 * ROWB + quad * 16;
    bf16x8 qf[4], kf[2][4];
#pragma unroll
    for (int ks = 0; ks < 4; ++ks) qf[ks] = *(const LAS bf16x8*)(qp + ks * 64);
#pragma unroll
    for (int sb = 0; sb < 2; ++sb)
#pragma unroll
        for (int ks = 0; ks < 4; ++ks) kf[sb][ks] = *(const LAS bf16x8*)(kp0 + sb * 16 * ROWB + ks * 64);
    s16x4 vlo[4][2], vhi[4][2];
#pragma unroll
    for (int d = 0; d < 4; ++d)
#pragma unroll
        for (int s2 = 0; s2 < 2; ++s2) { vlo[d][s2] = vtr(vp + (32 * s2) * ROWB + (dh * 4 + d) * 32); vhi[d][s2] = vtr(vp + (32 * s2 + 16) * ROWB + (dh * 4 + d) * 32); }
    __builtin_amdgcn_sched_barrier(0);
    f32x4 pt[4];
#pragma unroll
    for (int sb = 0; sb < 2; ++sb) {
        pt[sb] = z4;
#pragma unroll
        for (int ks = 0; ks < 4; ++ks) pt[sb] = MFMA16(kf[sb][ks], qf[ks], pt[sb]);
    }
    __builtin_amdgcn_sched_barrier(0);
#pragma unroll
    for (int sb = 0; sb < 2; ++sb)
#pragma unroll
        for (int ks = 0; ks < 4; ++ks) kf[sb][ks] = *(const LAS bf16x8*)(kp0 + (sb + 2) * 16 * ROWB + ks * 64);
    __builtin_amdgcn_sched_barrier(0);
#pragma unroll
    for (int sb = 0; sb < 2; ++sb) {
        pt[sb + 2] = z4;
#pragma unroll
        for (int ks = 0; ks < 4; ++ks) pt[sb + 2] = MFMA16(kf[sb][ks], qf[ks], pt[sb + 2]);
    }
    __builtin_amdgcn_sched_barrier(0);
#pragma unroll
    for (int ks = 0; ks < 4; ++ks) qf[ks] = *(const LAS bf16x8*)(q2p + ks * 64);
    s16x4 slo[2][4], shi[2][4];
#pragma unroll
    for (int d = 0; d < 2; ++d)
#pragma unroll
        for (int ks = 0; ks < 4; ++ks) { slo[d][ks] = vtr(shp + (32 * ks) * ROWB + d * 32); shi[d][ks] = vtr(shp + (32 * ks + 16) * ROWB + d * 32); }
    __builtin_amdgcn_sched_barrier(0);
#pragma unroll
    for (int sb = 0; sb < 4; ++sb)
#pragma unroll
        for (int j = 0; j < 4; ++j) { const bool keep = (sb < tb) || (sb == tb && 4 * quad + j <= r16); pt[sb][j] = keep ? pt[sb][j] : 0.f; }
    bf16x8 pf[2];
#pragma unroll
    for (int s2 = 0; s2 < 2; ++s2) { v4u a; a.x = cvtpk(pt[2 * s2][0], pt[2 * s2][1]); a.y = cvtpk(pt[2 * s2][2], pt[2 * s2][3]); a.z = cvtpk(pt[2 * s2 + 1][0], pt[2 * s2 + 1][1]); a.w = cvtpk(pt[2 * s2 + 1][2], pt[2 * s2 + 1][3]);
        pf[s2] = __builtin_bit_cast(bf16x8, a); }
    f32x4 o[4];
#pragma unroll
    for (int d = 0; d < 4; ++d) {
        o[d] = MFMA16(__builtin_shufflevector(vlo[d][0], vhi[d][0], 0, 1, 2, 3, 4, 5, 6, 7), pf[0], z4);
        o[d] = MFMA16(__builtin_shufflevector(vlo[d][1], vhi[d][1], 0, 1, 2, 3, 4, 5, 6, 7), pf[1], o[d]);
    }
#pragma unroll
    for (int d = 0; d < 2; ++d)
#pragma unroll
        for (int ks = 0; ks < 4; ++ks) o[d] = MFMA16(__builtin_shufflevector(slo[d][ks], shi[d][ks], 0, 1, 2, 3, 4, 5, 6, 7), qf[ks], o[d]);
    __builtin_amdgcn_sched_barrier(0);
#pragma unroll
    for (int d = 0; d < 2; ++d)
#pragma unroll
        for (int ks = 0; ks < 4; ++ks) { slo[d][ks] = vtr(shp + (32 * ks) * ROWB + (d + 2) * 32); shi[d][ks] = vtr(shp + (32 * ks + 16) * ROWB + (d + 2) * 32); }
    __builtin_amdgcn_sched_barrier(0);
#pragma unroll
    for (int d = 0; d < 2; ++d)
#pragma unroll
        for (int ks = 0; ks < 4; ++ks) o[d + 2] = MFMA16(__builtin_shufflevector(slo[d][ks], shi[d][ks], 0, 1, 2, 3, 4, 5, 6, 7), qf[ks], o[d + 2]);
    float ss = 0.f;
#pragma unroll
    for (int d = 0; d < 4; ++d) ss += (o[d][0] * o[d][0] + o[d][1] * o[d][1]) + (o[d][2] * o[d][2] + o[d][3] * o[d][3]);
    ss += __shfl_xor(ss, 16); ss += __shfl_xor(ss, 32);
    LAS float* rp = (LAS float*)(lds + RMSP + par * 512);
    if (quad == 0) rp[dh * 64 + tb * 16 + r16] = ss;
    __syncthreads();
    {
        const float ms = (rp[tb * 16 + r16] + rp[64 + tb * 16 + r16]) * (1.0f / 128.0f);
        const float rn = 1.0f / sqrtf(ms + RMS_EPS);
        bf16* yo = Y + orow * 1024 + 512 + colh + 4 * quad;
#pragma unroll
        for (int d = 0; d < 4; ++d) {
            const int db = dh * 4 + d;
            const f32x4 g4 = *(const GAS f32x4*)(norm_g + db * 16 + 4 * quad);
            const float g0 = __uint_as_float(gbv[d].x << 16), g1 = __uint_as_float(gbv[d].x & 0xffff0000u), g2 = __uint_as_float(gbv[d].y << 16), g3 = __uint_as_float(gbv[d].y & 0xffff0000u);
            u32x2 wv; wv.x = cvtpk(o[d][0] * rn * g4[0] * g0, o[d][1] * rn * g4[1] * g1); wv.y = cvtpk(o[d][2] * rn * g4[2] * g2, o[d][3] * rn * g4[3] * g3);
            *(GAS u32x2*)(yo + db * 16) = wv;
        }
    }
}
}

typedef float f32x2 __attribute__((ext_vector_type(2)));
__device__ __forceinline__ void p4_ln_row(f32x4 (&v)[4], const float* ln1g, const float* ln1b, bf16* H1B, float* ST1, int r, int lane) {
    float s = 0.f;
#pragma unroll
    for (int j = 0; j < 4; ++j) s += (v[j].x + v[j].y) + (v[j].z + v[j].w);
    const float mean = wave_sum(s) * (1.f / D); float s2 = 0.f;
#pragma unroll
    for (int j = 0; j < 4; ++j) { v[j] = v[j] - mean; s2 += (v[j].x * v[j].x + v[j].y * v[j].y) + (v[j].z * v[j].z + v[j].w * v[j].w); }
    const float rstd = 1.f / sqrtf(wave_sum(s2) * (1.f / D) + LN_EPS);
    GAS unsigned long long* o8 = (GAS unsigned long long*)(H1B + (size_t)r * D) + lane;
#pragma unroll
    for (int j = 0; j < 4; ++j) { v[j] = v[j] * rstd * ((const GAS f32x4*)ln1g)[lane + 64 * j] + ((const GAS f32x4*)ln1b)[lane + 64 * j];
        if constexpr (FP8_GU) ((GAS unsigned*)((unsigned char*)H1B + (size_t)r * D))[lane + 64 * j] = pg8::pk4_fp8(v[j].x, v[j].y, v[j].z, v[j].w);
        else o8[64 * j] = (unsigned long long)pk2(v[j].x, v[j].y) | ((unsigned long long)pk2(v[j].z, v[j].w) << 32); }
    if (lane == 0) { ST1[2 * r] = mean; ST1[2 * r + 1] = rstd; }
}
__device__ __forceinline__ void p4_route2(float logit, int lane, int r, int tl, float* GATES, LAS int* lcnt, LAS int* sel, LAS float* scr) {
    const int e = lane & 31, h = lane >> 5;
    LAS float* sc = scr + 64 * h;
    sc[e] = logit;
    asm volatile("s_waitcnt lgkmcnt(0)" ::: "memory");
    int rank = 0;
#pragma unroll
    for (int q = 0; q < 8; ++q) {
        const f32x4 o = *(const LAS f32x4*)(sc + 4 * q);
        rank += (o.x > logit || (o.x == logit && 4 * q + 0 < e)) ? 1 : 0; rank += (o.y > logit || (o.y == logit && 4 * q + 1 < e)) ? 1 : 0;
        rank += (o.z > logit || (o.z == logit && 4 * q + 2 < e)) ? 1 : 0; rank += (o.w > logit || (o.w == logit && 4 * q + 3 < e)) ? 1 : 0;
    }
    const bool win = rank < 4;
    if (win) sc[32 + rank] = logit;
    asm volatile("s_waitcnt lgkmcnt(0)" ::: "memory");
    const f32x4 top = *(const LAS f32x4*)(sc + 32);
    const float sume = 1.0f + expf(top.y - top.x) + expf(top.z - top.x) + expf(top.w - top.x);
    if (win) {
        GATES[(r + h) * 4 + rank] = expf(logit - top.x) / sume;
        const int lp = __hip_atomic_fetch_add(lcnt + e, 1, __ATOMIC_RELAXED, __HIP_MEMORY_SCOPE_WORKGROUP);
        sel[(tl + h) * 4 + rank] = (e << 16) | lp;
    }
    asm volatile("s_waitcnt lgkmcnt(0)" ::: "memory");
}
__device__ __forceinline__ void p4_split_row(const f32x4 (&v)[4], LAS unsigned char* AH, LAS unsigned char* AL, int lr, int lane) {
#pragma unroll
    for (int j = 0; j < 4; ++j) {
        const unsigned h0 = pg8::cvt_pk_bf16(v[j].x, v[j].y), h1 = pg8::cvt_pk_bf16(v[j].z, v[j].w);
        const float hx = __builtin_bit_cast(float, h0 << 16), hy = __builtin_bit_cast(float, h0 & 0xffff0000u), hz = __builtin_bit_cast(float, h1 << 16), hw = __builtin_bit_cast(float, h1 & 0xffff0000u);
        const unsigned l0 = pg8::cvt_pk_bf16(v[j].x - hx, v[j].y - hy), l1 = pg8::cvt_pk_bf16(v[j].z - hz, v[j].w - hw);
        const int chunk = (lane >> 1) + 32 * j, addr = lr * 2048 + ((chunk ^ (lr & 15)) << 4) + (lane & 1) * 8;
        *(LAS pg8::u32x2*)(AH + addr) = (pg8::u32x2){h0, h1}; *(LAS pg8::u32x2*)(AL + addr) = (pg8::u32x2){l0, l1};
    }
}
__device__ __forceinline__ void wave_sum4(float (&s)[4]) {
#pragma unroll
    for (int o = 1; o < 64; o <<= 1) { float t[4];
#pragma unroll
        for (int k = 0; k < 4; ++k) t[k] = __shfl_xor(s[k], o);
#pragma unroll
        for (int k = 0; k < 4; ++k) s[k] += t[k]; }
}
__device__ __forceinline__ void p4_ln_rows4(f32x4 (&v)[4][4], const f32x4 (&g)[4], const f32x4 (&b)[4], bf16* H1B, float* ST1, int r0, int lane) {
    float s[4], s2[4];
#pragma unroll
    for (int k = 0; k < 4; ++k) { s[k] = 0.f;
#pragma unroll
        for (int j = 0; j < 4; ++j) s[k] += (v[k][j].x + v[k][j].y) + (v[k][j].z + v[k][j].w); }
    wave_sum4(s);
#pragma unroll
    for (int k = 0; k < 4; ++k) { s[k] *= (1.f / D); s2[k] = 0.f;
#pragma unroll
        for (int j = 0; j < 4; ++j) { v[k][j] = v[k][j] - s[k]; s2[k] += (v[k][j].x * v[k][j].x + v[k][j].y * v[k][j].y) + (v[k][j].z * v[k][j].z + v[k][j].w * v[k][j].w); } }
    wave_sum4(s2);
#pragma unroll
    for (int k = 0; k < 4; ++k) {
        const float rstd = 1.f / sqrtf(s2[k] * (1.f / D) + LN_EPS);
#pragma unroll
        for (int j = 0; j < 4; ++j) { v[k][j] = v[k][j] * rstd * g[j] + b[j];
            ((GAS unsigned*)((unsigned char*)H1B + (size_t)(r0 + k) * D))[lane + 64 * j] = pg8::pk4_fp8(v[k][j].x, v[k][j].y, v[k][j].z, v[k][j].w); }
        if (lane == 0) { ST1[2 * (r0 + k)] = s[k]; ST1[2 * (r0 + k) + 1] = rstd; }
    }
}
__device__ __forceinline__ void p4_router(const Frame& F, unsigned char* ws, const float* ln1g, const float* ln1b, const float* b_router, int cw_cnt) {
    const int tid = F.tid, lane = F.lane, w = F.wave;
    LAS unsigned char* AH = F.lds + RING_OFF; LAS unsigned char* AL = AH + 65536;
    LAS float* part = (LAS float*)(F.lds + LDSCTL_OFF + 8192);
    LAS int* lcnt = (LAS int*)(F.lds + LCNT_OFF); LAS int* gbase = (LAS int*)(F.lds + GBASE_OFF); LAS int* sel = (LAS int*)(F.lds + SEL_OFF);
    const float* PRE1 = (const float*)(ws + WS_PRE1); bf16* H1B = (bf16*)(ws + WS_H1B); float* ST1 = (float*)(ws + WS_ST1);
    float* GATES = (float*)(ws + WS_GATES); int* TSLOT = (int*)(ws + WS_TSLOT); int* LIST = (int*)(ws + WS_LIST);
    int* cnt = (int*)(ws + WS_CTL) + cw_cnt;
    const float brt = b_router[lane & 31];
    LAS float* rscr = (LAS float*)(F.lds + LDSCTL_OFF + 4096 + w * 512);
    const int r16 = lane & 15, quad = lane >> 4, rb = w & 1, eb = (w >> 1) & 1, kh = w >> 2;
    f32x4 g4[4], b4[4];
#pragma unroll
    for (int j = 0; j < 4; ++j) { g4[j] = ((const GAS f32x4*)ln1g)[lane + 64 * j]; b4[j] = ((const GAS f32x4*)ln1b)[lane + 64 * j]; }
    const bf16* bhp = (const bf16*)(ws + WS_WRT) + (size_t)(eb * 16 + r16) * D + kh * 512 + quad * 8; const bf16* blp = bhp + NE * D;
    for (int grp = F.vcu; grp < MR / 64; grp += F.G) {
        if (tid < 32) lcnt[tid] = 0;
        __syncthreads();
#pragma unroll 1
        for (int rd = 0; rd < 2; ++rd) {
            { const int lr = 4 * w, r0 = grp * 64 + rd * 32 + lr;
              f32x4 v[4][4];
#pragma unroll
              for (int k = 0; k < 4; ++k) { const GAS f32x4* xa = (const GAS f32x4*)(PRE1 + (size_t)(r0 + k) * D) + lane;
#pragma unroll
                  for (int j = 0; j < 4; ++j) v[k][j] = xa[64 * j]; }
              p4_ln_rows4(v, g4, b4, H1B, ST1, r0, lane);
#pragma unroll
              for (int k = 0; k < 4; ++k) p4_split_row(v[k], AH, AL, lr + k, lane);
            }
            __syncthreads();
            { f32x4 acc = {0.f, 0.f, 0.f, 0.f};
              const int arow = rb * 16 + r16;
#pragma unroll
              for (int s = 0; s < 16; ++s) {
                  const int chunk = kh * 64 + 4 * s + quad, aaddr = arow * 2048 + ((chunk ^ r16) << 4);
                  const bf16x8 ah = *(const LAS bf16x8*)(AH + aaddr), al = *(const LAS bf16x8*)(AL + aaddr);
                  const bf16x8 bh = *(const GAS bf16x8*)(bhp + 32 * s), bl = *(const GAS bf16x8*)(blp + 32 * s);
                  acc = MFMA16(ah, bh, acc); acc = MFMA16(ah, bl, acc); acc = MFMA16(al, bh, acc);
              }
#pragma unroll
              for (int v = 0; v < 4; ++v) part[(kh * 32 + rb * 16 + 4 * quad + v) * 32 + eb * 16 + r16] = acc[v];
            }
            __syncthreads();
#pragma unroll 1
            for (int i = 0; i < 4; i += 2) {
                const int lr = 4 * w + i, tl = rd * 32 + lr;
                const float logit = part[lr * 32 + lane] + part[1024 + lr * 32 + lane] + brt;
                p4_route2(logit, lane, grp * 64 + tl, tl, GATES, lcnt, sel, rscr);
            }
        }
        __syncthreads();
        if (tid < 32) gbase[tid] = __hip_atomic_fetch_add(cnt + tid, lcnt[tid], RLX_AGENT);
        __syncthreads();
        if (tid < 256) { const int sv = sel[tid], e = sv >> 16, pos = gbase[e] + (sv & 0xffff), r = grp * 64 + (tid >> 2); LIST[e * MR + pos] = r; TSLOT[r * 4 + (tid & 3)] = (e << 16) | pos; }
        __syncthreads();
    }
}

__device__ __forceinline__ void moe_tile_prefix(const Frame& F, unsigned char* ws) {
    if (F.wave == 0) {
        const int* cnt = (const int*)(ws + WS_CTL) + CW_CNT;
        int n = (F.lane < 32) ? (__hip_atomic_load(cnt + (F.lane & 31), RLX_AGENT) + 255) >> 8 : 0;
#pragma unroll
        for (int o = 1; o < 32; o <<= 1) { const int t = __shfl_up(n, o); if ((F.lane & 31) >= o) n += t; }
        LAS int* tpre = (LAS int*)(F.lds + TPRE_OFF);
        if (F.lane < 32) tpre[F.lane + 1] = n;
        if (F.lane == 0) tpre[0] = 0;
    }
    __syncthreads();
}
typedef float f32x2v __attribute__((ext_vector_type(2)));
struct P7A { f32x4 v[4]; float mu, rs; int sp[4]; float gt[4]; };
struct P7Y { unsigned y[4][4]; };
__device__ __forceinline__ void p7_loadA(P7A& a, int r, int lane, const float* PRE1, const float* ST1, const int* TSLOT, const float* GATES) {
    const GAS f32x4* xr = (const GAS f32x4*)(PRE1 + (size_t)r * D) + lane;
#pragma unroll
    for (int j = 0; j < 4; ++j) a.v[j] = xr[64 * j];
    a.mu = ST1[2 * r]; a.rs = ST1[2 * r + 1];
#pragma unroll
    for (int k = 0; k < 4; ++k) { a.sp[k] = TSLOT[r * 4 + k]; a.gt[k] = GATES[r * 4 + k]; }
}
__device__ __forceinline__ void p7_loadY(P7Y& y, const P7A& a, int lane, const unsigned char* YE, const LAS int* tpre) {
#pragma unroll
    for (int k = 0; k < 4; ++k) {
        const int e = a.sp[k] >> 16, pos = a.sp[k] & 0xffff;
        const GAS unsigned* yr = (const GAS unsigned*)(YE + ((size_t)tpre[e] * 256 + pos) * D) + lane;
#pragma unroll
        for (int j = 0; j < 4; ++j) y.y[k][j] = yr[64 * j];
    }
}
__device__ __forceinline__ void p7_final(const Frame& F, unsigned char* ws, const float* ln1g, const float* ln1b, const float* ln2g, const float* ln2b, float* out) {
    static_assert(FP8_YE, "p7_final reads fp8 expert outputs");
    const int lane = F.lane;
    const int gw = F.vcu * NWAVES + F.wave, NGW = F.G * NWAVES;
    const float* PRE1 = (const float*)(ws + WS_PRE1); const float* ST1 = (const float*)(ws + WS_ST1);
    const float* GATES = (const float*)(ws + WS_GATES); const int* TSLOT = (const int*)(ws + WS_TSLOT); const unsigned char* YE = (const unsigned char*)(ws + WS_YE);
    const LAS int* tpre = (const LAS int*)(F.lds + TPRE_OFF);
    P7A a0, a1, a2; P7Y y0, y1;
    if (gw < MR) { p7_loadA(a0, gw, lane, PRE1, ST1, TSLOT, GATES); p7_loadY(y0, a0, lane, YE, tpre); }
    if (gw + NGW < MR) p7_loadA(a1, gw + NGW, lane, PRE1, ST1, TSLOT, GATES);
    for (int r = gw; r < MR; r += NGW) {
        if (r + 2 * NGW < MR) p7_loadA(a2, r + 2 * NGW, lane, PRE1, ST1, TSLOT, GATES);
        if (r + NGW < MR) p7_loadY(y1, a1, lane, YE, tpre);
        f32x4 v[4];
#pragma unroll
        for (int j = 0; j < 4; ++j) { const f32x4 gv = ((const GAS f32x4*)ln1g)[lane + 64 * j], bv = ((const GAS f32x4*)ln1b)[lane + 64 * j]; v[j] = ((a0.v[j] - a0.mu) * a0.rs * gv + bv) * ALPHA; }
#pragma unroll
        for (int k = 0; k < 4; ++k) {
            const float g8 = a0.gt[k] * (1.0f / YE_SCALE);
#pragma unroll
            for (int j = 0; j < 4; ++j) { const int y = (int)y0.y[k][j]; const f32x2v lo = __builtin_amdgcn_cvt_pk_f32_fp8(y, false), hi = __builtin_amdgcn_cvt_pk_f32_fp8(y, true);
                v[j].x += g8 * lo.x; v[j].y += g8 * lo.y; v[j].z += g8 * hi.x; v[j].w += g8 * hi.y; }
        }
        float s = 0.f;
#pragma unroll
        for (int j = 0; j < 4; ++j) s += (v[j].x + v[j].y) + (v[j].z + v[j].w);
        const float mean = wave_sum(s) * (1.f / D); float s2 = 0.f;
#pragma unroll
        for (int j = 0; j < 4; ++j) { v[j] = v[j] - mean; s2 += (v[j].x * v[j].x + v[j].y * v[j].y) + (v[j].z * v[j].z + v[j].w * v[j].w); }
        const float rstd = 1.f / sqrtf(wave_sum(s2) * (1.f / D) + LN_EPS);
        GAS f32x4* orow = (GAS f32x4*)(out + (size_t)r * D) + lane;
#pragma unroll
        for (int j = 0; j < 4; ++j) { const f32x4 gv = ((const GAS f32x4*)ln2g)[lane + 64 * j], bv = ((const GAS f32x4*)ln2b)[lane + 64 * j]; orow[64 * j] = v[j] * rstd * gv + bv; }
        a0 = a1; a1 = a2; y0 = y1;
    }
}

struct Args { const float* in[23]; float* out; unsigned char* ws; int ph_lo, ph_hi; };
__global__ void __launch_bounds__(NWAVES * 64, 2) mega_fwd(Args args) {
    extern __shared__ __attribute__((aligned(16))) unsigned char lds[];
    Frame F;
    F.lds = (LAS unsigned char*)lds;
    F.MISC = (volatile LAS unsigned*)(F.lds + MISC_OFF);
    F.tid = threadIdx.x; F.lane = F.tid & 63; F.wave = __builtin_amdgcn_readfirstlane(F.tid >> 6);
    F.G = gridDim.x; { const int bx = blockIdx.x; F.vcu = (F.G % 8 == 0) ? (bx % 8) * (F.G / 8) + bx / 8 : bx; }
    unsigned char* ws = args.ws;
    F.ctl = (gu32*)(ws + WS_CTL);
    for (int u = F.tid; u < (LDS_BYTES - LDSCTL_OFF) / 4; u += NWAVES * 64) ((LAS unsigned*)(F.lds + LDSCTL_OFF))[u] = 0u;
    __syncthreads();
    XcdBarrier bar = xcd_barrier_post((unsigned*)(F.ctl + CW_BAR), F.MISC + 8);
    const int lo = args.ph_lo, hi = args.ph_hi;
#define IN(k) (lo <= (k) && (k) < hi)
#define BOTH(k) (IN(k) && IN((k) + 1))

    if (IN(0)) {
        P0Args a{args.in[0], args.in[1], args.in[2], args.in[3], args.in[4], args.in[12], args.in[17], args.in[19], args.in[10], args.in[15]};
        p0_prologue(F, a, ws);
        if (BOTH(0)) xcd_barrier(bar);
    }
    if (IN(1)) {
        pg8::Gemm g{(const pg8::bf16_t*)(ws + WS_H0B), (const pg8::bf16_t*)(ws + WS_WIN), MP, DIN, D};
        pg8::StaticOrder S; S.init(MP, DIN, F.G, (int)blockIdx.x);
        pg8::EpiProj E{(pg8::bf16_t*)(ws + WS_QA), (pg8::bf16_t*)(ws + WS_KA), (pg8::bf16_t*)(ws + WS_VA), (pg8::bf16_t*)(ws + WS_QB), (pg8::bf16_t*)(ws + WS_VB), (pg8::bf16_t*)(ws + WS_GB),
                       (float*)(ws + WS_LF), (const float*)(ws + WS_ROPE), (const float*)(ws + WS_LB)};
        pg8::gemm_phase<pg8::EpiProj, pg8::StaticOrder, true>(F.lds + RING_OFF, g, S, E);
        if (F.G == 256 && (int)blockIdx.x >= P1_SHORT0) conv_job(F, (int)blockIdx.x - P1_SHORT0, args.in[17], args.in[19], ws);
        if (BOTH(1)) xcd_barrier(bar);
    }
    if (IN(2)) {
        float lam;
        { const float a = wave_sum(args.in[5][F.lane] * args.in[6][F.lane]), c = wave_sum(args.in[7][F.lane] * args.in[8][F.lane]); lam = expf(a) - expf(c) + LAM_INIT; }
        const float* LFp = (const float*)(ws + WS_LF); const bf16* QBp = (const bf16*)(ws + WS_QB); const bf16* VBp = (const bf16*)(ws + WS_VB); const bf16* GBp = (const bf16*)(ws + WS_GB);
        bf16* UHp = (bf16*)(ws + WS_UH); float* ELp = (float*)(ws + WS_EL); bf16* SPp = (bf16*)(ws + WS_SP);
        constexpr int QJOBS = 132 + 64 + 32 + 96 + 132;
        static_assert(CONV_JOBS == 768 && hg::NUNIT == 8 * 132, "queue layout assumes 512 attention units, 768 conversion jobs and 1056 HGRN2 units");
        const int myx = (int)(xb_xcc_id() & 7u);
        int cpar = 0;
        for (int sx = 0; sx < 8; ++sx) {
            const int x = (myx + sx) & 7;
            if (F.tid == 0) F.MISC[0] = __hip_atomic_fetch_add(F.ctl + CW_JOB + 64 * x, 1u, RLX_AGENT);
            __syncthreads();
            int job = __builtin_amdgcn_readfirstlane((int)F.MISC[0]);
            __syncthreads();
            while (job < QJOBS) {
                unsigned nextj = 0u;
                if (F.tid == 0) nextj = __hip_atomic_fetch_add(F.ctl + CW_JOB + 64 * x, 1u, RLX_AGENT);
                int ua = -1, sj = -1, cv = -1, cu = -1, au = -1;
                if (job < 132) ua = job;
                else if (job < 196) { const int k = job - 132; if (k & 1) cv = k >> 1; else au = k >> 1; }
                else if (job < 228) sj = job - 196;
                else if (job < 324) { const int k = job - 228; if (k >= 64) cv = k; else if (k & 1) cv = 32 + (k >> 1); else au = 32 + (k >> 1); }
                else cu = job - 324;
                if (ua >= 0) { const int u = x * 132 + ua; hg::hgA_unit(F, u, cpar, LFp, VBp, UHp, ELp, F.ctl + CW_HGA + 64 * (u / 33)); cpar ^= 1; }
                else if (sj >= 0) { const int bh = 4 * x + (sj >> 3), wq = sj & 7;
                    hg::hg_wait(F, F.ctl + CW_HGA + 64 * bh, 33u);
                    hg::hg_scan_job((bh << 6) | (wq << 3) | F.wave, F.lane, UHp, ELp, SPp);
                    hg::hg_arrive(F, F.ctl + CW_HGS + 64 * bh); }
                else if (cv >= 0) { const int cid = (F.G == 256) ? CONV_P1 + x * CONV_PER_X + cv : x * 96 + cv; if (F.G != 256 || (cv < CONV_PER_X && cid < CONV_JOBS)) conv_job(F, cid, args.in[17], args.in[19], ws); }
                else if (cu >= 0) { const int u = x * 132 + cu; hg::hgC_unit(F, u, cpar, QBp, LFp, VBp, GBp, SPp, (bf16*)(ws + WS_Y), args.in[11], F.ctl + CW_HGS + 64 * (u / 33)); cpar ^= 1; }
                else { const int i = 15 - au / 4, bh = 4 * x + (au & 3);
                    att::attn_unit(F, bh >> 2, bh & 3, i, (const bf16*)(ws + WS_QA), (const bf16*)(ws + WS_KA), (const bf16*)(ws + WS_VA), (bf16*)(ws + WS_Y), lam, args.in[9]); }
                __syncthreads();
                if (F.tid == 0) F.MISC[0] = nextj;
                __syncthreads();
                job = __builtin_amdgcn_readfirstlane((int)F.MISC[0]);
                __syncthreads();
            }
        }
        if (BOTH(2)) xcd_barrier(bar);
    }
    if (IN(3)) {
        pg8::Gemm g{(const pg8::bf16_t*)(ws + WS_Y), (const pg8::bf16_t*)(ws + WS_WOUT), MR, D, D};
        pg8::StaticOrderT<true> S; S.init(MR, D, F.G, (int)blockIdx.x);
        pg8::EpiOut E{args.in[0], (const float*)(ws + WS_STATS), args.in[2], args.in[3], (float*)(ws + WS_PRE1)};
        pg8::gemm_phase<pg8::EpiOut, pg8::StaticOrderT<true>, true>(F.lds + RING_OFF, g, S, E);
        if (BOTH(3)) xcd_barrier(bar);
    }
    if (IN(4)) {
        p4_router(F, ws, args.in[13], args.in[14], args.in[16], CW_CNT);
        if (BOTH(4)) xcd_barrier(bar);
    }
    if (IN(5)) {
        moe_tile_prefix(F, ws);
        pg8::Gemm g{(const pg8::bf16_t*)(ws + WS_H1B), (const pg8::bf16_t*)(ws + WS_WGU), 0, 2 * D, FP8_GU ? D / 2 : D};
        pg8::GroupedOrder<true> S{(const LAS int*)(F.lds + TPRE_OFF), (const int*)(ws + WS_CTL) + CW_CNT, (const int*)(ws + WS_LIST), 3, F.G, F.vcu, (size_t)2 * D * D * (FP8_GU ? 1 : 2)};
        pg8::EpiGU<FP8_DN> E{args.in[18], (pg8::bf16_t*)(ws + WS_ACT), FP8_GU ? 1.0f / W_GU_SCALE : 1.0f};
        pg8::gemm_phase<pg8::EpiGU<FP8_DN>, pg8::GroupedOrder<true>, true, FP8_GU>(F.lds + RING_OFF, g, S, E);
        if (BOTH(5)) {
            if (MOE_SPLIT_SEAM && F.G == 256) {
                const int Rr = (8 * ((const LAS int*)(F.lds + TPRE_OFF))[32]) & 255;
                asm volatile("s_waitcnt vmcnt(0)" ::: "memory");
                __syncthreads();
                if (F.tid == 0) { __builtin_amdgcn_fence(__ATOMIC_RELEASE, "agent"); asm volatile("s_waitcnt vmcnt(0)" ::: "memory");
                    __hip_atomic_fetch_add(F.ctl + CW_GRP + (F.vcu < Rr ? 64 : 0), 1u, RLX_AGENT); }
            } else xcd_barrier(bar);
        }
    }
    if (IN(6)) {
        moe_tile_prefix(F, ws);
        pg8::Gemm g{(const pg8::bf16_t*)(ws + WS_ACT), (const pg8::bf16_t*)(ws + WS_WDN), 0, D, FP8_DN ? D / 2 : D};
        pg8::EpiDN<FP8_YE> E{args.in[20], (pg8::bf16_t*)(ws + WS_YE), FP8_DN ? 1.0f / W_DN_SCALE : 1.0f, YE_SCALE};
        if (MOE_SPLIT_SEAM && F.G == 256 && BOTH(5)) {
            const int Rr = (8 * ((const LAS int*)(F.lds + TPRE_OFF))[32]) & 255;
            pg8::SplitOrder S{(const LAS int*)(F.lds + TPRE_OFF), (unsigned*)(ws + WS_CTL) + CW_GRP, F.G, F.vcu, Rr, (size_t)D * D * (FP8_DN ? 1 : 2), 0u};
            pg8::gemm_phase<pg8::EpiDN<FP8_YE>, pg8::SplitOrder, true, FP8_DN>(F.lds + RING_OFF, g, S, E);
        } else {
            pg8::GroupedOrder<false> S{(const LAS int*)(F.lds + TPRE_OFF), (const int*)(ws + WS_CTL) + CW_CNT, nullptr, 2, F.G, F.vcu, (size_t)D * D * (FP8_DN ? 1 : 2)};
            pg8::gemm_phase<pg8::EpiDN<FP8_YE>, pg8::GroupedOrder<false>, true, FP8_DN>(F.lds + RING_OFF, g, S, E);
        }
        if (BOTH(6)) xcd_barrier(bar);
    }
    if (IN(7)) {
        moe_tile_prefix(F, ws);
        p7_final(F, ws, args.in[13], args.in[14], args.in[21], args.in[22], args.out);
    }
#undef IN
#undef BOTH
}


extern "C" void kernel_launch(void* const* d_in, const int* in_sizes, int n_in, void* d_out, int out_size, void* d_ws, size_t ws_size, hipStream_t stream) {
    static int grid = 0;
    if (grid == 0) {
        int dev = 0, cus = 0;
        if (hipGetDevice(&dev) != hipSuccess || hipDeviceGetAttribute(&cus, hipDeviceAttributeMultiprocessorCount, dev) != hipSuccess) { fprintf(stderr, "kernel_launch: device query failed\n"); grid = -1; return; }
        if (hipFuncSetAttribute((const void*)mega_fwd, hipFuncAttributeMaxDynamicSharedMemorySize, LDS_BYTES) != hipSuccess) { fprintf(stderr, "kernel_launch: hipFuncSetAttribute failed\n"); grid = -1; return; }
        int per_cu = 0;
        if (hipOccupancyMaxActiveBlocksPerMultiprocessor(&per_cu, (const void*)mega_fwd, NWAVES * 64, LDS_BYTES) != hipSuccess || per_cu < 1) fprintf(stderr, "kernel_launch: occupancy query reports %d\n", per_cu);
        (void)hipGetLastError();
        grid = cus;
    }
    if (grid < 0) return;
    (void)in_sizes; (void)n_in; (void)out_size; (void)ws_size;
    unsigned char* ws = (unsigned char*)d_ws;
    if (hipMemsetAsync(ws + WS_CTL, 0, CTL_ZERO_BYTES, stream) != hipSuccess) { fprintf(stderr, "kernel_launch: memset failed\n"); return; }
    Args a{};
    for (int i = 0; i < 23; ++i) a.in[i] = (const float*)d_in[i];
    a.out = (float*)d_out; a.ws = ws; a.ph_lo = 0; a.ph_hi = 8;
    hipLaunchKernelGGL(mega_fwd, dim3(grid), dim3(NWAVES * 64), LDS_BYTES, stream, a);

}
```

```cpp
#include <hip/hip_runtime.h>
#include <cstdio>
#include <cstdint>
namespace pg8 {
#define PG8_LAS __attribute__((address_space(3)))
typedef unsigned short bf16_t;
typedef short bf16x8 __attribute__((ext_vector_type(8)));
typedef float f32x4 __attribute__((ext_vector_type(4)));
typedef unsigned u32x4 __attribute__((ext_vector_type(4)));
constexpr int BM = 256, BK = 64, HALF = 128, HTB = HALF * BK * 2  , STAGE_BYTES = 8 * HTB, NXCD = 8, WGM = 8;

__host__ __device__ __forceinline__ int lds_byte(int r, int c) { const int st = (r >> 4) * 2 + (c >> 5), rr = r & 15, cc = c & 31, ob = rr * 64 + cc * 2; return st * 1024 + (ob ^ (((ob >> 9) & 1) << 5)); }
__host__ __device__ __forceinline__ void stage_rc(int b, int& R, int& C) { const int st = b / 1024, sb = b % 1024, swz = sb ^ (((sb >> 9) & 1) << 5); R = (st >> 1) * 16 + swz / 64; C = (st & 1) * 32 + (swz % 64) / 2; }
__host__ __device__ __forceinline__ int perm32(int rho) { const int n = rho >> 4, i = rho & 15; return 8 * (i >> 2) + 4 * n + (i & 3); }

struct Unit { int pm, pn, e; };
struct Gemm { const bf16_t* A; const bf16_t* Bt; int M, N, K; };

template <bool AMAP> struct StaticOrderT {
    static constexpr bool UNIFORM_AOFF = true;
    __device__ __forceinline__ void a_ready(const Unit&) const {}
    int nM, nN, nwg, G, c;
    __host__ __device__ void init(int M, int N, int G_, int c_) { nM = M / BM; nN = N / BM; nwg = nM * nN; G = G_; c = c_; }
    __host__ __device__ bool next(int i, Unit& u) const {
        const long L = (long)i * G + c; if (L >= nwg) return false;
        int wgid = (int)L; { const int q = nwg / NXCD, r = nwg % NXCD, xcd = wgid % NXCD, off = wgid / NXCD; wgid = (xcd < r ? xcd * (q + 1) : r * (q + 1) + (xcd - r) * q) + off; }
        const int nig = WGM * nN, gid = wgid / nig, fm = gid * WGM, gsz = (nM - fm) < WGM ? (nM - fm) : WGM;
        u.pm = fm + ((wgid % nig) % gsz); u.pn = (wgid % nig) / gsz; u.e = 0; return true;
    }
    __device__ __forceinline__ const char* a_base(const Gemm& g, const Unit& u) const { const size_t row = AMAP ? (size_t)(u.pm >> 3) * 2112 + 64 + (size_t)(u.pm & 7) * 256 : (size_t)u.pm * 256; return (const char*)g.A + row * g.K * 2; }
    __device__ __forceinline__ const char* b_base(const Gemm& g, const Unit& u) const { return (const char*)g.Bt + (size_t)u.pn * 256 * g.K * 2; }
    __device__ __forceinline__ void a_offs(const Gemm& g, const Unit&, int tid, unsigned (&vo)[2][2]) const {
#pragma unroll
        for (int i = 0; i < 2; ++i) { int R, C; stage_rc(tid * 16 + i * 8192, R, C); vo[0][i] = (unsigned)(R * g.K + C) * 2u; vo[1][i] = (unsigned)((R + HALF) * g.K + C) * 2u; }
    }
};
typedef StaticOrderT<false> StaticOrder;
template <bool GATHER> struct GroupedOrder {
    static constexpr bool UNIFORM_AOFF = !GATHER;
    __device__ __forceinline__ void a_ready(const Unit&) const {}
    const PG8_LAS int* tpre; const int* cnt; const int* list; int nct_shift, G, c; size_t bstride;
    __device__ __forceinline__ bool next(int i, Unit& u) const {
        const int L = i * G + c, ntot = tpre[32]; const int tile = L >> nct_shift;
        if (tile >= ntot) return false;
        int e = 0;
        for (int k = 1; k < 32; ++k) e += (tile >= tpre[k]) ? 1 : 0;
        u.pm = __builtin_amdgcn_readfirstlane(tile); u.pn = L & ((1 << nct_shift) - 1); u.e = __builtin_amdgcn_readfirstlane(e); return true;
    }
    __device__ __forceinline__ const char* a_base(const Gemm& g, const Unit& u) const { return GATHER ? (const char*)g.A : (const char*)g.A + (size_t)u.pm * 256 * g.K * 2; }
    __device__ __forceinline__ const char* b_base(const Gemm& g, const Unit& u) const { return (const char*)g.Bt + (size_t)u.e * bstride + (size_t)u.pn * 256 * g.K * 2; }
    __device__ __forceinline__ void a_offs(const Gemm& g, const Unit& u, int tid, unsigned (&vo)[2][2]) const {
#pragma unroll
        for (int i = 0; i < 2; ++i) { int R, C; stage_rc(tid * 16 + i * 8192, R, C);
            if (GATHER) {
                const int n = cnt[u.e], lr = (u.pm - tpre[u.e]) * 256 + R;
                const int t0 = lr < n ? list[u.e * 16384 + lr] : 0, t1 = lr + HALF < n ? list[u.e * 16384 + lr + HALF] : 0;
                vo[0][i] = (unsigned)(t0 * g.K + C) * 2u; vo[1][i] = (unsigned)(t1 * g.K + C) * 2u;
            } else { vo[0][i] = (unsigned)(R * g.K + C) * 2u; vo[1][i] = (unsigned)((R + HALF) * g.K + C) * 2u; }
        }
    }
};

struct SplitOrder {
    static constexpr bool UNIFORM_AOFF = true;
    const PG8_LAS int* tpre; unsigned* gctr; int G, vcu, R; size_t bstride;
    __device__ __forceinline__ int pos2tile(int p, int ntiles) const {
        const int q = R >> 3, nfull = ntiles >> 5, rem = ntiles & 31, nef = 32 - q;
        const int E1 = nfull * nef, Er = rem > q ? rem - q : 0;
        if (p < E1) return 32 * (p / nef) + q + p % nef;
        if (p < E1 + Er) return 32 * nfull + q + (p - E1);
        const int p2 = p - E1 - Er;
        if (p2 < nfull * q) return 32 * (p2 / q) + p2 % q;
        return 32 * nfull + (p2 - nfull * q);
    }
    __device__ __forceinline__ bool next(int i, Unit& u) const {
        const int ntiles = tpre[32], rank = vcu >= R ? vcu - R : vcu + (G - R);
        const int L = i * G + rank, p = L >> 2;
        if (p >= ntiles) return false;
        const int tile = pos2tile(p, ntiles);
        int e = 0;
        for (int k = 1; k < 32; ++k) e += (tile >= tpre[k]) ? 1 : 0;
        u.pm = __builtin_amdgcn_readfirstlane(tile); u.pn = L & 3; u.e = __builtin_amdgcn_readfirstlane(e); return true;
    }
    mutable unsigned seen;
    __device__ __forceinline__ void a_ready(const Unit& u) const {
        const bool late = (u.pm & 31) < (R >> 3);
        const unsigned bit = late ? 2u : 1u;
        if (seen & bit) return;
        seen |= bit;
        if (threadIdx.x < 64) {
            const unsigned target = late ? (unsigned)R : (unsigned)(G - R);
            unsigned* c = gctr + (late ? 64 : 0); unsigned sp = 0;
            while ((unsigned)__builtin_amdgcn_readfirstlane(__hip_atomic_load(c, __ATOMIC_RELAXED, __HIP_MEMORY_SCOPE_AGENT)) < target && ++sp < (1u << 22)) __builtin_amdgcn_s_sleep(2);
            __builtin_amdgcn_fence(__ATOMIC_ACQUIRE, "agent");
            asm volatile("s_waitcnt vmcnt(0)" ::: "memory");
        }
        asm volatile("" ::: "memory"); __builtin_amdgcn_s_barrier(); asm volatile("" ::: "memory");
    }
    __device__ __forceinline__ const char* a_base(const Gemm& g, const Unit& u) const { return (const char*)g.A + (size_t)u.pm * 256 * g.K * 2; }
    __device__ __forceinline__ const char* b_base(const Gemm& g, const Unit& u) const { return (const char*)g.Bt + (size_t)u.e * bstride + (size_t)u.pn * 256 * g.K * 2; }
    __device__ __forceinline__ void a_offs(const Gemm& g, const Unit&, int tid, unsigned (&vo)[2][2]) const {
#pragma unroll
        for (int i = 0; i < 2; ++i) { int Rr, C; stage_rc(tid * 16 + i * 8192, Rr, C); vo[0][i] = (unsigned)(Rr * g.K + C) * 2u; vo[1][i] = (unsigned)((Rr + HALF) * g.K + C) * 2u; }
    }
};

struct P1Order {
    static constexpr bool UNIFORM_AOFF = true;
    int base, stride, n, nN, nunits, first_wait; unsigned* lnc;
    mutable unsigned long long seen0, seen1;
    __device__ __forceinline__ bool next(int i, Unit& u) const {
        if (i >= n) return false;
        const int L = base + i * stride; if (L >= nunits) return false;
        u.pm = L / nN; u.pn = L - u.pm * nN; u.e = 0; return true;
    }
    __device__ __forceinline__ void a_ready(const Unit& u) const {
        if (u.pm < first_wait) return;
        const unsigned long long bit = 1ull << (u.pm & 63);
        if ((u.pm < 64 ? seen0 : seen1) & bit) return;
        if (u.pm < 64) seen0 |= bit; else seen1 |= bit;
        if (threadIdx.x < 64) {
            unsigned* c = lnc + 64 * u.pm; unsigned sp = 0;
            while ((unsigned)__builtin_amdgcn_readfirstlane(__hip_atomic_load(c, __ATOMIC_RELAXED, __HIP_MEMORY_SCOPE_AGENT)) < 256u && ++sp < (1u << 22)) __builtin_amdgcn_s_sleep(2);
            __builtin_amdgcn_fence(__ATOMIC_ACQUIRE, "agent");
            asm volatile("s_waitcnt vmcnt(0)" ::: "memory");
        }
        asm volatile("" ::: "memory"); __builtin_amdgcn_s_barrier(); asm volatile("" ::: "memory");
    }
    __device__ __forceinline__ const char* a_base(const Gemm& g, const Unit& u) const { return (const char*)g.A + (size_t)u.pm * 256 * g.K * 2; }
    __device__ __forceinline__ const char* b_base(const Gemm& g, const Unit& u) const { return (const char*)g.Bt + (size_t)u.pn * 256 * g.K * 2; }
    __device__ __forceinline__ void a_offs(const Gemm& g, const Unit&, int tid, unsigned (&vo)[2][2]) const {
#pragma unroll
        for (int i = 0; i < 2; ++i) { int Rr, C; stage_rc(tid * 16 + i * 8192, Rr, C); vo[0][i] = (unsigned)(Rr * g.K + C) * 2u; vo[1][i] = (unsigned)((Rr + HALF) * g.K + C) * 2u; }
    }
};

__device__ __forceinline__ unsigned cvt_pk_bf16(float lo, float hi) { unsigned r; asm volatile("v_cvt_pk_bf16_f32 %0, %1, %2" : "=v"(r) : "v"(lo), "v"(hi)); return r; }
typedef float f32x2 __attribute__((ext_vector_type(2)));

typedef int v8i32_t __attribute__((ext_vector_type(8)));
typedef int v4i32_t __attribute__((ext_vector_type(4)));
__device__ __forceinline__ v8i32_t cat8(bf16x8 lo, bf16x8 hi) { const v4i32_t a = __builtin_bit_cast(v4i32_t, lo), b = __builtin_bit_cast(v4i32_t, hi); return __builtin_shufflevector(a, b, 0, 1, 2, 3, 4, 5, 6, 7); }
__device__ __forceinline__ unsigned pk4_fp8(float a, float b, float c, float d) {
    a = fminf(fmaxf(a, -448.f), 448.f); b = fminf(fmaxf(b, -448.f), 448.f); c = fminf(fmaxf(c, -448.f), 448.f); d = fminf(fmaxf(d, -448.f), 448.f);
    int p = __builtin_amdgcn_cvt_pk_fp8_f32(a, b, 0, false); p = __builtin_amdgcn_cvt_pk_fp8_f32(c, d, p, true); return (unsigned)p;
}
__device__ __forceinline__ unsigned pk4_fp8_nc(float a, float b, float c, float d) {
    int p = __builtin_amdgcn_cvt_pk_fp8_f32(a, b, 0, false); p = __builtin_amdgcn_cvt_pk_fp8_f32(c, d, p, true); return (unsigned)p;
}
__device__ __forceinline__ float fast_sigmoid(float x) { return __builtin_amdgcn_rcpf(1.0f + __builtin_amdgcn_exp2f(-1.4426950408889634f * x)); }
typedef unsigned u32x2 __attribute__((ext_vector_type(2)));
constexpr int LPAD = 2112;
struct EpiProj {
    static constexpr bool PERM = true, AFTER_DRAIN = false;
    bf16_t *QA, *KA, *VA, *QB, *VB, *GB; float* LF; const float* rope; const float* lb;
    __device__ __forceinline__ void operator()(const f32x4 (&acc)[2][2][4][2], const Unit& u, int wr, int wc, int fr, int fq) const {
        const int g = u.pn >> 1;
        const int colg = (u.pn & 1) * 256 + wc * 32 + 8 * fq;
        const int row0 = u.pm * BM + wr * 64 + fr;
        if (g <= 1) {
            bf16_t* O = g == 0 ? QA : KA; const float sc = g == 0 ? 0.125f * 1.4426950408889634f : 1.0f;
            const int j = (wc & 1) * 16 + 4 * fq;
            f32x4 cs[8][2];
#pragma unroll
            for (int rg = 0; rg < 8; ++rg) { const int t = (row0 + (rg >> 2) * HALF + (rg & 3) * 16) % LPAD; const float* rp = rope + (size_t)(t * 32 + j) * 2; cs[rg][0] = *(const f32x4*)rp; cs[rg][1] = *(const f32x4*)(rp + 4); }
#pragma unroll
            for (int rg = 0; rg < 8; ++rg) {
                const int ai = rg >> 2, m = rg & 3, r = row0 + ai * HALF + m * 16;
                const f32x4 cs0 = cs[rg][0], cs1 = cs[rg][1];
#pragma unroll
                for (int bj = 0; bj < 2; ++bj) {
                    const f32x4 v0 = acc[ai][bj][m][0], v1 = acc[ai][bj][m][1];
                    u32x4 w;
                    w.x = cvt_pk_bf16((v0[0] * cs0[0] - v0[1] * cs0[1]) * sc, (v0[1] * cs0[0] + v0[0] * cs0[1]) * sc);
                    w.y = cvt_pk_bf16((v0[2] * cs0[2] - v0[3] * cs0[3]) * sc, (v0[3] * cs0[2] + v0[2] * cs0[3]) * sc);
                    w.z = cvt_pk_bf16((v1[0] * cs1[0] - v1[1] * cs1[1]) * sc, (v1[1] * cs1[0] + v1[0] * cs1[1]) * sc);
                    w.w = cvt_pk_bf16((v1[2] * cs1[2] - v1[3] * cs1[3]) * sc, (v1[3] * cs1[2] + v1[2] * cs1[3]) * sc);
                    *(u32x4*)(O + (size_t)r * 512 + colg + bj * HALF) = w;
                }
            }
        } else if (g == 4) {
            f32x4 l0[2], l1[2];
#pragma unroll
            for (int bj = 0; bj < 2; ++bj) { l0[bj] = *(const f32x4*)(lb + colg + bj * HALF); l1[bj] = *(const f32x4*)(lb + colg + bj * HALF + 4); }
#pragma unroll
            for (int ai = 0; ai < 2; ++ai)
#pragma unroll
                for (int m = 0; m < 4; ++m) {
                    const int r = row0 + ai * HALF + m * 16;
#pragma unroll
                    for (int bj = 0; bj < 2; ++bj) {
                        const f32x4 v0 = acc[ai][bj][m][0], v1 = acc[ai][bj][m][1]; f32x4 o0, o1;
#pragma unroll
                        for (int e = 0; e < 4; ++e) {
                            o0[e] = __builtin_amdgcn_logf(l0[bj][e] + (1.0f - l0[bj][e]) * fast_sigmoid(v0[e]));
                            o1[e] = __builtin_amdgcn_logf(l1[bj][e] + (1.0f - l1[bj][e]) * fast_sigmoid(v1[e]));
                        }
                        float* p = LF + (size_t)r * 512 + colg + bj * HALF;
                        *(f32x4*)p = o0; *(f32x4*)(p + 4) = o1;
                    }
                }
        } else {
            bf16_t* O = g == 2 ? VA : (g == 3 ? QB : (g == 5 ? VB : GB));
            const int mode = (g == 3) ? 1 : (g == 6 ? 2 : 0);
#pragma unroll
            for (int ai = 0; ai < 2; ++ai)
#pragma unroll
                for (int m = 0; m < 4; ++m) {
                    const int r = row0 + ai * HALF + m * 16;
#pragma unroll
                    for (int bj = 0; bj < 2; ++bj) {
                        f32x4 v0 = acc[ai][bj][m][0], v1 = acc[ai][bj][m][1];
                        if (mode) {
                            const float sc = mode == 1 ? 0.08838834764831845f : 1.0f;
#pragma unroll
                            for (int e = 0; e < 4; ++e) { v0[e] = v0[e] * fast_sigmoid(v0[e]) * sc; v1[e] = v1[e] * fast_sigmoid(v1[e]) * sc; }
                        }
                        u32x4 w; w.x = cvt_pk_bf16(v0[0], v0[1]); w.y = cvt_pk_bf16(v0[2], v0[3]); w.z = cvt_pk_bf16(v1[0], v1[1]); w.w = cvt_pk_bf16(v1[2], v1[3]);
                        *(u32x4*)(O + (size_t)r * 512 + colg + bj * HALF) = w;
                    }
                }
        }
    }
};


struct EpiOut {
    static constexpr bool PERM = false, AFTER_DRAIN = false;
    const float* x; const float* stats; const float* g; const float* b; float* pre1;
    __device__ __forceinline__ void operator()(const f32x4 (&acc)[2][2][4][2], const Unit& u, int wr, int wc, int fr, int fq) const {
        const int col0 = u.pn * BM + wc * 32 + 4 * fq;
        const int row0 = u.pm * BM + wr * 64 + fr;
        f32x4 gv[2][2], bv[2][2];
#pragma unroll
        for (int bj = 0; bj < 2; ++bj)
#pragma unroll
            for (int n = 0; n < 2; ++n) { const int c = col0 + bj * HALF + n * 16; gv[bj][n] = *(const f32x4*)(g + c); bv[bj][n] = *(const f32x4*)(b + c); }
        f32x4 xb[2][2][2]; f32x2 st[2];
        { const size_t r = (size_t)row0; st[0] = *(const f32x2*)(stats + 2 * r); const float* xr = x + r * 1024 + col0;
#pragma unroll
          for (int bj = 0; bj < 2; ++bj)
#pragma unroll
              for (int n = 0; n < 2; ++n) xb[0][bj][n] = __builtin_nontemporal_load((const f32x4*)(xr + bj * HALF + n * 16)); }
#pragma unroll
        for (int rg = 0; rg < 8; ++rg) {
            if (rg + 1 < 8) { const size_t r = (size_t)(row0 + ((rg + 1) >> 2) * HALF + ((rg + 1) & 3) * 16); st[(rg + 1) & 1] = *(const f32x2*)(stats + 2 * r); const float* xr = x + r * 1024 + col0;
#pragma unroll
                for (int bj = 0; bj < 2; ++bj)
#pragma unroll
                    for (int n = 0; n < 2; ++n) xb[(rg + 1) & 1][bj][n] = __builtin_nontemporal_load((const f32x4*)(xr + bj * HALF + n * 16)); }
            const int ai = rg >> 2, m = rg & 3;
            const float mu = st[rg & 1].x, rs = st[rg & 1].y;
            float* pr = pre1 + (size_t)(row0 + ai * HALF + m * 16) * 1024 + col0;
#pragma unroll
            for (int bj = 0; bj < 2; ++bj)
#pragma unroll
                for (int n = 0; n < 2; ++n) *(f32x4*)(pr + bj * HALF + n * 16) = ((xb[rg & 1][bj][n] - mu) * rs * gv[bj][n] + bv[bj][n]) * 1.189207115002721f + acc[ai][bj][m][n];
        }
    }
};
template <bool OUT8> struct EpiGU {
    static constexpr bool PERM = true, AFTER_DRAIN = false;
    const float* bias; bf16_t* act; float scale;
    __device__ __forceinline__ static float swiglu(float gt, float up) { gt = fminf(gt, 7.0f); up = fminf(fmaxf(up, -7.0f), 7.0f); return (up + 1.0f) * gt * fast_sigmoid(1.702f * gt); }
    static constexpr float KS = 1.702f * 1.4426950408889634f;
    __device__ __forceinline__ static float swiglu_s(float gs, float us) { gs = fminf(gs, 7.0f * KS); us = fminf(fmaxf(us, -6.0f / KS), 8.0f / KS); return us * gs * __builtin_amdgcn_rcpf(1.0f + __builtin_amdgcn_exp2f(-gs)); }
    __device__ __forceinline__ void operator()(const f32x4 (&acc)[2][2][4][2], const Unit& u, int wr, int wc, int fr, int fq) const {
        const int col0 = u.pn * BM + wc * 32 + 8 * fq;
        const float* bb = bias + (size_t)u.e * 2048 + col0;
        f32x4 b0[2], b1[2];
#pragma unroll
        for (int bj = 0; bj < 2; ++bj) { b0[bj] = *(const f32x4*)(bb + bj * HALF); b1[bj] = *(const f32x4*)(bb + bj * HALF + 4); }
        if constexpr (OUT8) {
            const f32x4 sv = {scale * KS, scale / KS, scale * KS, scale / KS};
#pragma unroll
            for (int bj = 0; bj < 2; ++bj) {
                b0[bj] = (f32x4){b0[bj][0] * KS, (b0[bj][1] + 1.0f) * (1.0f / KS), b0[bj][2] * KS, (b0[bj][3] + 1.0f) * (1.0f / KS)};
                b1[bj] = (f32x4){b1[bj][0] * KS, (b1[bj][1] + 1.0f) * (1.0f / KS), b1[bj][2] * KS, (b1[bj][3] + 1.0f) * (1.0f / KS)}; }
            const int msel = fq >> 1, bsel = fq & 1;
#pragma unroll
            for (int ai = 0; ai < 2; ++ai)
#pragma unroll
                for (int mp = 0; mp < 4; mp += 2) {
                    unsigned P[2][2];
#pragma unroll
                    for (int mm = 0; mm < 2; ++mm)
#pragma unroll
                        for (int bj = 0; bj < 2; ++bj) {
                            const f32x4 v0 = acc[ai][bj][mp + mm][0] * sv + b0[bj], v1 = acc[ai][bj][mp + mm][1] * sv + b1[bj];
                            P[mm][bj] = pk4_fp8_nc(swiglu_s(v0[0], v0[1]), swiglu_s(v0[2], v0[3]), swiglu_s(v1[0], v1[1]), swiglu_s(v1[2], v1[3]));
                        }
                    const auto s0 = __builtin_amdgcn_permlane16_swap(P[0][0], P[0][1], false, false);
                    const auto s1 = __builtin_amdgcn_permlane16_swap(P[1][0], P[1][1], false, false);
                    const auto t0 = __builtin_amdgcn_permlane32_swap(s0[0], s1[0], false, false);
                    const auto t1 = __builtin_amdgcn_permlane32_swap(s0[1], s1[1], false, false);
                    u32x4 w; w.x = t0[0]; w.y = t1[0]; w.z = t0[1]; w.w = t1[1];
                    const size_t r = (size_t)u.pm * BM + ai * HALF + wr * 64 + (mp + msel) * 16 + fr;
                    *(u32x4*)((unsigned char*)act + r * 1024 + u.pn * 128 + wc * 16 + bsel * 64) = w;
                }
        } else {
#pragma unroll
            for (int ai = 0; ai < 2; ++ai)
#pragma unroll
                for (int m = 0; m < 4; ++m) {
                    const size_t r = (size_t)u.pm * BM + ai * HALF + wr * 64 + m * 16 + fr;
#pragma unroll
                    for (int bj = 0; bj < 2; ++bj) {
                        const f32x4 v0 = acc[ai][bj][m][0] * scale + b0[bj], v1 = acc[ai][bj][m][1] * scale + b1[bj];
                        u32x2 w; w.x = cvt_pk_bf16(swiglu(v0[0], v0[1]), swiglu(v0[2], v0[3])); w.y = cvt_pk_bf16(swiglu(v1[0], v1[1]), swiglu(v1[2], v1[3]));
                        *(u32x2*)(act + r * 1024 + ((col0 + bj * HALF) >> 1)) = w;
                    }
                }
        }
    }
};
template <bool OUT8> struct EpiDN {
    static constexpr bool PERM = true, AFTER_DRAIN = false;
    const float* bias; bf16_t* ye; float scale, oscale;
    __device__ __forceinline__ void operator()(const f32x4 (&acc)[2][2][4][2], const Unit& u, int wr, int wc, int fr, int fq) const {
        const int col0 = u.pn * BM + wc * 32 + 8 * fq;
        const float* bb = bias + (size_t)u.e * 1024 + col0;
        f32x4 b0[2], b1[2];
#pragma unroll
        for (int bj = 0; bj < 2; ++bj) { b0[bj] = *(const f32x4*)(bb + bj * HALF); b1[bj] = *(const f32x4*)(bb + bj * HALF + 4); }
        const float so = OUT8 ? scale * oscale : scale;
        if constexpr (OUT8) {
#pragma unroll
            for (int bj = 0; bj < 2; ++bj) { b0[bj] = b0[bj] * oscale; b1[bj] = b1[bj] * oscale; }
        }
#pragma unroll
        for (int ai = 0; ai < 2; ++ai)
#pragma unroll
            for (int m = 0; m < 4; ++m) {
                const size_t r = (size_t)u.pm * BM + ai * HALF + wr * 64 + m * 16 + fr;
                if constexpr (OUT8) {
                    unsigned A[2][2];
#pragma unroll
                    for (int bj = 0; bj < 2; ++bj) {
                        const f32x4 v0 = acc[ai][bj][m][0] * so + b0[bj], v1 = acc[ai][bj][m][1] * so + b1[bj];
                        A[bj][0] = pk4_fp8(v0[0], v0[1], v0[2], v0[3]); A[bj][1] = pk4_fp8(v1[0], v1[1], v1[2], v1[3]);
                    }
                    const auto s0 = __builtin_amdgcn_permlane16_swap(A[0][0], A[1][0], false, false);
                    const auto s1 = __builtin_amdgcn_permlane16_swap(A[0][1], A[1][1], false, false);
                    u32x4 w; w.x = s0[0]; w.y = s1[0]; w.z = s0[1]; w.w = s1[1];
                    *(u32x4*)((unsigned char*)ye + r * 1024 + u.pn * BM + wc * 32 + (fq & 1) * HALF + 16 * (fq >> 1)) = w;
                } else {
#pragma unroll
                    for (int bj = 0; bj < 2; ++bj) {
                        const f32x4 v0 = acc[ai][bj][m][0] * scale + b0[bj], v1 = acc[ai][bj][m][1] * scale + b1[bj];
                        u32x4 w; w.x = cvt_pk_bf16(v0[0], v0[1]); w.y = cvt_pk_bf16(v0[2], v0[3]); w.z = cvt_pk_bf16(v1[0], v1[1]); w.w = cvt_pk_bf16(v1[2], v1[3]);
                        *(u32x4*)(ye + r * 1024 + col0 + bj * HALF) = w;
                    }
                }
            }
    }
};

template <class Epi, class Sched, bool ALIGN_EPI = false, bool FP8 = false>
__device__ __forceinline__ void gemm_phase(PG8_LAS unsigned char* lds, const Gemm g, const Sched& S, const Epi& E) {
    const int tid = threadIdx.x, wid = __builtin_amdgcn_readfirstlane(tid >> 6), lane = tid & 63, wr = wid >> 2, wc = wid & 3, fr = lane & 15, fq = lane >> 4;
    const int K = g.K, nt = K / BK;
    unsigned voffB[2];
#pragma unroll
    for (int i = 0; i < 2; ++i) { int R, C; stage_rc(tid * 16 + i * 8192, R, C); const int Rb = Epi::PERM ? ((R & ~31) + perm32(R & 31)) : R; voffB[i] = (unsigned)(Rb * K + C) * 2u; }
    const size_t kstep = (size_t)(BK * 2);
    const size_t hstep = (size_t)HALF * K * 2;
    const unsigned ldsw = (unsigned)wid * 1024u;
    const int aoff = lds_byte(wr * 64 + fr, fq * 8), boff = lds_byte(wc * 32 + fr, fq * 8);
#define PG8_SA(b, h) (((b) * 2 + (h)) * HTB)
#define PG8_SB(b, h) ((4 + (b) * 2 + (h)) * HTB)
#define PG8_STAGE2(bufoff, gbase, v0, v1) do { \
        __builtin_amdgcn_global_load_lds((const unsigned*)((const char*)(gbase) + (v0)), (PG8_LAS unsigned*)(lds + (bufoff) + ldsw), 16, 0, 0); \
        __builtin_amdgcn_global_load_lds((const unsigned*)((const char*)(gbase) + (v1)), (PG8_LAS unsigned*)(lds + (bufoff) + ldsw + 8192), 16, 0, 0); } while (0)
#define PG8_STAGEB(bufoff, gbase) PG8_STAGE2(bufoff, gbase, voffB[0], voffB[1])
#define PG8_LDA(dst, b, h) do { _Pragma("unroll") for (int m = 0; m < 4; ++m) _Pragma("unroll") for (int k = 0; k < 2; ++k) dst[m][k] = *(const PG8_LAS bf16x8*)(lds + PG8_SA(b, h) + aoff + m * 2048 + k * 1024); } while (0)
#define PG8_LDB(dst, b, h) do { _Pragma("unroll") for (int n = 0; n < 2; ++n) _Pragma("unroll") for (int k = 0; k < 2; ++k) dst[n][k] = *(const PG8_LAS bf16x8*)(lds + PG8_SB(b, h) + boff + n * 2048 + k * 1024); } while (0)
#define PG8_MMA(ai, bj, At, Bt) do { __builtin_amdgcn_s_setprio(1); _Pragma("unroll") for (int m = 0; m < 4; ++m) _Pragma("unroll") for (int n = 0; n < 2; ++n) _Pragma("unroll") for (int k = 0; k < 2; ++k) \
        acc[ai][bj][m][n] = __builtin_amdgcn_mfma_f32_16x16x32_bf16(Bt[n][k], At[m][k], acc[ai][bj][m][n], 0, 0, 0); __builtin_amdgcn_s_setprio(0); } while (0)
#define PG8_MMA8(ai, bj, At, Bt) do { __builtin_amdgcn_s_setprio(1); _Pragma("unroll") for (int m = 0; m < 4; ++m) _Pragma("unroll") for (int n = 0; n < 2; ++n) \
        asm volatile("v_mfma_scale_f32_16x16x128_f8f6f4 %0, %1, %2, %0, %3, %3 op_sel_hi:[0,0,0]" : "+v"(acc[ai][bj][m][n]) : "v"(cat8(Bt[n][0], Bt[n][1])), "v"(cat8(At[m][0], At[m][1])), "v"(0x7f7f7f7f)); \
        __builtin_amdgcn_s_setprio(0); } while (0)
#define PG8_MM(ai, bj, At, Bt) do { if constexpr (FP8) PG8_MMA8(ai, bj, At, Bt); else PG8_MMA(ai, bj, At, Bt); } while (0)
#define PG8_WAIT_V(n) asm volatile("s_waitcnt vmcnt(" #n ")" ::: "memory")
#define PG8_WAIT_L(n) asm volatile("s_waitcnt lgkmcnt(" #n ")" ::: "memory")
#define PG8_BAR __builtin_amdgcn_s_barrier()
#define PG8_SCHED __builtin_amdgcn_sched_barrier(0)
    Unit cur, nxt; int ui = 0;
    if (!S.next(0, cur)) return;
    f32x4 acc[2][2][4][2];
#pragma unroll
    for (int a = 0; a < 2; ++a)
#pragma unroll
        for (int b = 0; b < 2; ++b)
#pragma unroll
            for (int m = 0; m < 4; ++m)
#pragma unroll
                for (int n = 0; n < 2; ++n) acc[a][b][m][n] = (f32x4){0.f, 0.f, 0.f, 0.f};
    bf16x8 At[4][2], B0[2][2], B1[2][2];
    unsigned vc[2][2], vn[2][2];
    S.a_ready(cur);
    S.a_offs(g, cur, tid, vc);
    const char* cA = S.a_base(g, cur); const char* cB = S.b_base(g, cur);
    PG8_STAGEB(PG8_SB(0, 0), cB); PG8_STAGEB(PG8_SB(0, 1), cB + hstep); PG8_STAGE2(PG8_SA(0, 0), cA, vc[0][0], vc[0][1]); PG8_STAGE2(PG8_SA(0, 1), cA, vc[1][0], vc[1][1]);
    if (wr == 1) PG8_BAR;
    PG8_WAIT_V(2); PG8_BAR;
    PG8_STAGEB(PG8_SB(1, 0), cB + kstep); PG8_STAGE2(PG8_SA(1, 0), cA + kstep, vc[0][0], vc[0][1]); PG8_STAGEB(PG8_SB(1, 1), cB + hstep + kstep);
    PG8_WAIT_V(6); PG8_BAR;
    for (;;) {
        const bool has_next = S.next(ui + 1, nxt);
        const char* nA = cA; const char* nB = cB;
        if (has_next) { nA = S.a_base(g, nxt); nB = S.b_base(g, nxt); if constexpr (!Sched::UNIFORM_AOFF) S.a_offs(g, nxt, tid, vn); }
        else if constexpr (!Sched::UNIFORM_AOFF) { vn[0][0] = vc[0][0]; vn[0][1] = vc[0][1]; vn[1][0] = vc[1][0]; vn[1][1] = vc[1][1]; }
#pragma unroll 1
        for (int t = 0; t < nt; t += 2) {
            const bool last = (t == nt - 2);
            if (last && has_next) S.a_ready(nxt);
            const char* a1 = cA + (size_t)(t + 1) * kstep;
            const char* a2 = last ? nA : cA + (size_t)(t + 2) * kstep; const char* b2 = last ? nB : cB + (size_t)(t + 2) * kstep;
            const char* a3 = a2 + kstep; const char* b3 = b2 + kstep;
            const unsigned w00 = (!Sched::UNIFORM_AOFF && last) ? vn[0][0] : vc[0][0], w01 = (!Sched::UNIFORM_AOFF && last) ? vn[0][1] : vc[0][1], w10 = (!Sched::UNIFORM_AOFF && last) ? vn[1][0] : vc[1][0], w11 = (!Sched::UNIFORM_AOFF && last) ? vn[1][1] : vc[1][1];
            PG8_LDB(B0, 0, 0); PG8_LDB(B1, 0, 1); PG8_SCHED; PG8_LDA(At, 0, 0); PG8_STAGE2(PG8_SA(1, 1), a1, vc[1][0], vc[1][1]);
            PG8_WAIT_V(8); PG8_WAIT_L(0); PG8_BAR; PG8_MM(0, 0, At, B0); PG8_MM(0, 1, At, B1); PG8_BAR; PG8_SCHED;
            PG8_LDA(At, 0, 1); PG8_STAGEB(PG8_SB(0, 0), b2); PG8_STAGEB(PG8_SB(0, 1), b2 + hstep); PG8_STAGE2(PG8_SA(0, 0), a2, w00, w01);
            PG8_WAIT_V(8); PG8_WAIT_L(0); PG8_BAR; PG8_MM(1, 0, At, B0); PG8_MM(1, 1, At, B1); PG8_BAR; PG8_SCHED;
            PG8_LDB(B0, 1, 0); PG8_LDB(B1, 1, 1); PG8_SCHED; PG8_LDA(At, 1, 0); PG8_STAGE2(PG8_SA(0, 1), a2, w10, w11);
            PG8_WAIT_V(8); PG8_WAIT_L(0); PG8_BAR; PG8_MM(0, 0, At, B0); PG8_MM(0, 1, At, B1); PG8_BAR; PG8_SCHED;
            PG8_LDA(At, 1, 1); PG8_STAGEB(PG8_SB(1, 0), b3); PG8_STAGEB(PG8_SB(1, 1), b3 + hstep); PG8_STAGE2(PG8_SA(1, 0), a3, w00, w01);
            PG8_WAIT_V(8); PG8_WAIT_L(0); PG8_BAR; PG8_MM(1, 0, At, B0); PG8_MM(1, 1, At, B1); PG8_BAR; PG8_SCHED;
        }
        if constexpr (ALIGN_EPI) { if (wr == 0) PG8_BAR; }
        if constexpr (FP8) asm volatile("s_nop 15\n\ts_nop 15" ::: "memory");
        E(acc, cur, wr, wc, fr, fq);
        if (!has_next) break;
#pragma unroll
        for (int a = 0; a < 2; ++a)
#pragma unroll
            for (int b = 0; b < 2; ++b)
#pragma unroll
                for (int m = 0; m < 4; ++m)
#pragma unroll
                    for (int n = 0; n < 2; ++n) acc[a][b][m][n] = (f32x4){0.f, 0.f, 0.f, 0.f};
        cur = nxt; cA = nA; cB = nB; ++ui;
        if constexpr (!Sched::UNIFORM_AOFF) { vc[0][0] = vn[0][0]; vc[0][1] = vn[0][1]; vc[1][0] = vn[1][0]; vc[1][1] = vn[1][1]; }
        if constexpr (ALIGN_EPI) { if (wr == 1) PG8_BAR; }
    }
    PG8_WAIT_V(0);
    if constexpr (!ALIGN_EPI) { if (wr == 0) PG8_BAR; }
    PG8_BAR;
#undef PG8_SA
#undef PG8_SB
#undef PG8_STAGE2
#undef PG8_STAGEB
#undef PG8_LDA
#undef PG8_LDB
#undef PG8_MMA
#undef PG8_MMA8
#undef PG8_MM
#undef PG8_WAIT_V
#undef PG8_WAIT_L
#undef PG8_BAR
#undef PG8_SCHED
}
}
#define GAS __attribute__((address_space(1)))
#define LAS __attribute__((address_space(3)))
typedef unsigned short bf16;
typedef unsigned v4u __attribute__((ext_vector_type(4)));
typedef float f32x4 __attribute__((ext_vector_type(4)));
typedef short bf16x8 __attribute__((ext_vector_type(8)));
typedef GAS unsigned gu32;
typedef GAS unsigned long long gu64;
#define RLX_AGENT __ATOMIC_RELAXED, __HIP_MEMORY_SCOPE_AGENT
#define LDS_WAIT() asm volatile("s_waitcnt lgkmcnt(0)" ::: "memory")
#define VM_WAIT() asm volatile("s_waitcnt vmcnt(0)" ::: "memory")
__device__ __forceinline__ unsigned long long rt() { return __builtin_amdgcn_s_memrealtime(); }
__device__ __forceinline__ unsigned f2bf(float f) { unsigned u = __builtin_bit_cast(unsigned, f); return (u + 0x7fffu + ((u >> 16) & 1u)) >> 16; }
__device__ __forceinline__ unsigned pk2(float lo, float hi) { return f2bf(lo) | (f2bf(hi) << 16); }

#define XB_TMO      128
#define XB_XCNT(j)  (256  + 64 * (j))
#define XB_XSUB(j)  (1280 + 64 * (j))
#define XB_XGEN(j)  (2304 + 64 * (j))
#define XB_TOP      3328
#define XB_TOPGEN   3392
#define XCD_BAR_WORDS 3456
#define XB_SPIN_CAP (1u << 18)

__device__ __forceinline__ unsigned xb_ld(unsigned* p)              { return __hip_atomic_load(p, __ATOMIC_RELAXED, __HIP_MEMORY_SCOPE_AGENT); }
__device__ __forceinline__ unsigned xb_add(unsigned* p, unsigned v) { return __hip_atomic_fetch_add(p, v, __ATOMIC_RELAXED, __HIP_MEMORY_SCOPE_AGENT); }
__device__ __forceinline__ unsigned xb_xcc_id() { return (unsigned)__builtin_amdgcn_s_getreg((3 << 11) | 20) & 0xFu; }
#define XB_SPIN(cond, bar) do { unsigned _sp = 0; while (cond) { __builtin_amdgcn_s_sleep(1); \
    if ((++_sp & 255u) == 0u) { if (xb_ld(&(bar)[XB_TMO])) break; if (_sp > XB_SPIN_CAP) { atomicAdd(&(bar)[XB_TMO], 1u); break; } } } } while (0)

struct XcdBarrier {
    unsigned* bar; unsigned x;
    volatile LAS unsigned* st;
};

__device__ __forceinline__ XcdBarrier xcd_barrier_post(unsigned* bar, volatile LAS unsigned* st) {
    XcdBarrier b; b.bar = bar; b.x = xb_xcc_id(); b.st = st;
    if (threadIdx.x == 0) (void)xb_add(&bar[XB_XCNT(b.x)], 1u);
    return b;
}
__device__ __forceinline__ void xcd_barrier_complete(unsigned* bar, unsigned x, unsigned& nloc, unsigned& nx) {
    const unsigned G = gridDim.x * gridDim.y * gridDim.z;
    unsigned sum, cnt, mine, sp = 0u;
    for (;;) {
        sum = 0u; cnt = 0u; mine = 0u;
#pragma unroll
        for (unsigned j = 0; j < 16; ++j) { const unsigned c = xb_ld(&bar[XB_XCNT(j)]); sum += c; cnt += (c > 0u) ? 1u : 0u; mine = (j == x) ? c : mine; }
        if (sum == G) break;
        __builtin_amdgcn_s_sleep(1);
        if ((++sp & 255u) == 0u) { if (xb_ld(&bar[XB_TMO])) break; if (sp > XB_SPIN_CAP) { atomicAdd(&bar[XB_TMO], 1u); break; } }
    }
    nloc = mine > 0u ? mine : 1u; nx = cnt > 0u ? cnt : 1u;
}

__device__ __forceinline__ void xcd_barrier(const XcdBarrier& b) {
    asm volatile("s_waitcnt vmcnt(0)" ::: "memory");
    __syncthreads();
    if (threadIdx.x == 0) {
        unsigned* bar = b.bar;
        __builtin_amdgcn_s_waitcnt(0);
        unsigned nloc = b.st[0], nx = b.st[1];
        if (nloc == 0u) { xcd_barrier_complete(bar, b.x, nloc, nx); b.st[0] = nloc; b.st[1] = nx; }
        const unsigned old = xb_add(&bar[XB_XSUB(b.x)], 1u);
        const unsigned gen = old / nloc;
        if (old + 1u == (gen + 1u) * nloc) {
            __builtin_amdgcn_fence(__ATOMIC_RELEASE, "agent");
            asm volatile("s_waitcnt vmcnt(0)" ::: "memory");
            const unsigned og = xb_add(&bar[XB_TOP], 1u);
            const unsigned tg = og / nx;
            if (og + 1u == (tg + 1u) * nx) xb_add(&bar[XB_TOPGEN], 1u);
            else XB_SPIN(xb_ld(&bar[XB_TOPGEN]) == tg, bar);
            __builtin_amdgcn_fence(__ATOMIC_ACQUIRE, "agent");
            xb_add(&bar[XB_XGEN(b.x)], 1u);
            asm volatile("s_waitcnt vmcnt(0)" ::: "memory");
        } else {
            XB_SPIN(xb_ld(&bar[XB_XGEN(b.x)]) == gen, bar);
            __builtin_amdgcn_fence(__ATOMIC_ACQUIRE, "agent");
            asm volatile("s_waitcnt vmcnt(0)" ::: "memory");
        }
    }
    __syncthreads();
}


constexpr int NWAVES = 8;
constexpr int D = 1024, NB = 8, SEQ = 2048, NMETA = 16, L = SEQ + NMETA, T = NB * L;
constexpr int LPAD = 2112, NPADR = 48, MP = NB * LPAD;
constexpr int MR = NB * SEQ;
constexpr int DIN = 3584, NE = 32, TOPK = 4;
constexpr float LN_EPS = 1e-5f, RMS_EPS = 1e-5f;
constexpr float ALPHA = 1.189207115002721f;
constexpr float LAM_INIT = 0.2f;
constexpr bool FP8_GU = true, FP8_DN = true;
constexpr float W_GU_SCALE = 32.f, W_DN_SCALE = 64.f;
constexpr bool FP8_YE = true;
constexpr float YE_SCALE = 8.f;

constexpr size_t MiB = 1u << 20;
constexpr size_t WS_CTL = 0, CTL_ZERO_BYTES = 1 * MiB;
constexpr size_t WS_WIN = 1 * MiB;
constexpr size_t WS_WOUT = 8 * MiB;
constexpr size_t WS_ROPE = 10 * MiB;
constexpr size_t WS_LB = 11 * MiB;
constexpr size_t WS_STATS = 11 * MiB + 65536;
constexpr size_t WS_WGU = 12 * MiB;
constexpr size_t WS_WDN = 140 * MiB;
constexpr size_t WS_H0B = 204 * MiB;
constexpr size_t SZ_P512 = (size_t)MP * 512 * 2;
constexpr size_t WS_QA = 237 * MiB, WS_KA = WS_QA + SZ_P512, WS_VA = WS_KA + SZ_P512, WS_QB = WS_VA + SZ_P512, WS_VB = WS_QB + SZ_P512, WS_GB = WS_VB + SZ_P512;
constexpr size_t WS_LF = 336 * MiB;
constexpr size_t WS_Y = 369 * MiB;
static_assert(WS_GB + SZ_P512 <= WS_LF && WS_LF + (size_t)MP * 512 * 4 <= WS_Y, "ws map");
constexpr size_t WS_WRT = 11 * MiB + 262144;
constexpr size_t WS_PRE1 = 402 * MiB;
constexpr size_t WS_H1B = 466 * MiB;
constexpr size_t WS_ST1 = 498 * MiB;
constexpr size_t WS_GATES = WS_ST1 + 262144;
constexpr size_t WS_TSLOT = WS_GATES + 262144;
constexpr size_t WS_LIST = 499 * MiB;
constexpr size_t WS_ACT = 502 * MiB;
constexpr size_t WS_YE = 646 * MiB;
constexpr size_t WS_UH = 790 * MiB;
constexpr size_t WS_SP = 856 * MiB;
constexpr size_t WS_EL = 889 * MiB;
constexpr int CW_BAR = 4096;
constexpr int CW_CNT = 16384;
constexpr int CW_GRP = 12288;
constexpr bool MOE_SPLIT_SEAM = true;
constexpr int CW_LN = 49152;
constexpr int CW_JOB = 8192;
constexpr int CW_HGA = 32768, CW_HGS = 32768 + 64 * 32;

constexpr int RING_OFF = 0, RING_BYTES = 131072;
constexpr int LDSCTL_OFF = RING_BYTES, MISC_OFF = LDSCTL_OFF + 320;
constexpr int LDS_BYTES = 147456;
constexpr int TPRE_OFF = LDSCTL_OFF + 512, LCNT_OFF = LDSCTL_OFF + 768, GBASE_OFF = LDSCTL_OFF + 1024, SEL_OFF = LDSCTL_OFF + 2048;

struct Frame {
    LAS unsigned char* lds;
    volatile LAS unsigned* MISC;
    gu32* ctl;
    int tid, lane, wave, vcu, G;
};
__device__ __forceinline__ float wave_sum(float v) {
#pragma unroll
    for (int o = 1; o < 64; o <<= 1) v += __shfl_xor(v, o);
    return v;
}
template <bool ROPEPERM>
__device__ __forceinline__ void p0_transpose_item(const float* W, int K, int N, bf16* WT, LAS float* scr, int item, int lane) {
    const int nblk = N / 32, kb = item / nblk, nb = item % nblk, k0 = 64 * kb, n0 = 32 * nb;
    f32x4 tv[8];
    const int r = lane >> 3, c4 = lane & 7;
#pragma unroll
    for (int i = 0; i < 8; ++i) tv[i] = __builtin_nontemporal_load((const GAS f32x4*)(W + (size_t)(k0 + 8 * r + i) * N + n0 + c4 * 4));
#pragma unroll
    for (int e = 0; e < 4; ++e) {
        v4u o; o.x = pk2(tv[0][e], tv[1][e]); o.y = pk2(tv[2][e], tv[3][e]); o.z = pk2(tv[4][e], tv[5][e]); o.w = pk2(tv[6][e], tv[7][e]);
        int nd = n0 + 4 * c4 + e;
        if (ROPEPERM && nd < 1024) { const int d = nd & 63; nd = (nd & ~63) | ((d & 31) << 1) | (d >> 5); }
        *(GAS v4u*)(WT + (size_t)nd * K + k0 + 8 * r) = o; }
}
constexpr int CONV_JOBS = (NE * (D / 64) * (2 * D / 32) + NE * (D / 64) * (D / 32)) / 64;
constexpr int P1_LN0 = 4096, P1_NPX = 12, P1_PU = 3;
constexpr int P1_SHORT0 = 156, CONV_P1 = 100, CONV_PER_X = 84;
template <int N> __device__ __forceinline__ void conv_load(f32x4 (&tv)[8], const float* W, int idx, int lane) {
    constexpr int nblk = N / 32; const int e = idx / (16 * nblk), rem = idx % (16 * nblk), k0 = 64 * (rem / nblk), n0 = 32 * (rem % nblk);
    const float* src = W + (size_t)e * D * N + (size_t)(k0 + 8 * (lane >> 3)) * N + n0 + (lane & 7) * 4;
#pragma unroll
    for (int i = 0; i < 8; ++i) tv[i] = __builtin_nontemporal_load((const GAS f32x4*)(src + (size_t)i * N));
}
template <int N, bool F8> __device__ __forceinline__ void conv_finish(const f32x4 (&tv)[8], bf16* WT, int idx, LAS float* scr, int lane, float scale) {
    constexpr int nblk = N / 32; const int e = idx / (16 * nblk), rem = idx % (16 * nblk), k0 = 64 * (rem / nblk), n0 = 32 * (rem % nblk);
    const int r = lane >> 3, c4 = lane & 7;
#pragma unroll
    for (int q = 0; q < 4; ++q) { const int n = n0 + 4 * c4 + q;
        if constexpr (F8) {
            pg8::u32x2 o; o.x = pg8::pk4_fp8(tv[0][q] * scale, tv[1][q] * scale, tv[2][q] * scale, tv[3][q] * scale); o.y = pg8::pk4_fp8(tv[4][q] * scale, tv[5][q] * scale, tv[6][q] * scale, tv[7][q] * scale);
            __builtin_nontemporal_store(o, (GAS pg8::u32x2*)((unsigned char*)WT + (size_t)e * N * D + (size_t)n * D + k0 + 8 * r));
        } else {
            v4u o; o.x = pk2(tv[0][q], tv[1][q]); o.y = pk2(tv[2][q], tv[3][q]); o.z = pk2(tv[4][q], tv[5][q]); o.w = pk2(tv[6][q], tv[7][q]);
            *(GAS v4u*)(WT + (size_t)e * N * D + (size_t)n * D + k0 + 8 * r) = o; }
    }
}
template <int N, bool F8> __device__ __forceinline__ void conv_items(const float* W, bf16* WT, int idx0, LAS float* scr, int lane, float scale) {
    f32x4 ta[8], tb[8], tc[8], td[8], te[8];
    conv_load<N>(ta, W, idx0, lane);
    conv_load<N>(tb, W, idx0 + 8, lane);
    conv_load<N>(tc, W, idx0 + 16, lane);
    conv_load<N>(td, W, idx0 + 24, lane);
    conv_load<N>(te, W, idx0 + 32, lane);  conv_finish<N, F8>(ta, WT, idx0, scr, lane, scale);
    conv_load<N>(ta, W, idx0 + 40, lane);  conv_finish<N, F8>(tb, WT, idx0 + 8, scr, lane, scale);
    conv_load<N>(tb, W, idx0 + 48, lane);  conv_finish<N, F8>(tc, WT, idx0 + 16, scr, lane, scale);
    conv_load<N>(tc, W, idx0 + 56, lane);  conv_finish<N, F8>(td, WT, idx0 + 24, scr, lane, scale);
    conv_finish<N, F8>(te, WT, idx0 + 32, scr, lane, scale);
    conv_finish<N, F8>(ta, WT, idx0 + 40, scr, lane, scale);
    conv_finish<N, F8>(tb, WT, idx0 + 48, scr, lane, scale);
    conv_finish<N, F8>(tc, WT, idx0 + 56, scr, lane, scale);
}
__device__ __forceinline__ void conv_job(const Frame& F, int v, const float* w_gu, const float* w_dn, unsigned char* ws) {
    LAS float* scr = (LAS float*)(F.lds + RING_OFF + F.wave * 16384);
    int lane = F.lane; asm volatile("" : "+v"(lane));
    if (v < 512) conv_items<2 * D, FP8_GU>(w_gu, (bf16*)(ws + WS_WGU), v * 64 + F.wave, scr, lane, W_GU_SCALE);
    else conv_items<D, FP8_DN>(w_dn, (bf16*)(ws + WS_WDN), (v - 512) * 64 + F.wave, scr, lane, W_DN_SCALE);
}
struct P0Args { const float *x, *meta, *g, *b, *w_in, *w_out, *w_gu, *w_dn, *lbt, *w_router; };
__device__ __forceinline__ void p0_prologue(Frame& F, const P0Args& a, unsigned char* ws, int ln_end) {
    LAS float* scr = (LAS float*)(F.lds + RING_OFF + F.wave * 16384);
    const int gw = F.vcu * NWAVES + F.wave, NGW = F.G * NWAVES;
    constexpr int I_IN = (D / 64) * (DIN / 32), I_OUT = (D / 64) * (D / 32);
    constexpr int NITEMS = I_IN + I_OUT;
    bf16* WIN = (bf16*)(ws + WS_WIN); bf16* WOUT = (bf16*)(ws + WS_WOUT);
    for (int it = gw; it < NITEMS; it += NGW) {
        int r = it;
        if (r < I_IN) { p0_transpose_item<true>(a.w_in, D, DIN, WIN, scr, r, F.lane); continue; } r -= I_IN;
        p0_transpose_item<false>(a.w_out, D, D, WOUT, scr, r, F.lane);
    }
    bf16* H0B = (bf16*)(ws + WS_H0B); float* STATS = (float*)(ws + WS_STATS);
    for (int pr = gw; pr < ln_end; pr += NGW) {
        const int bb = pr / LPAD, t = pr % LPAD;
        GAS unsigned long long* o8 = (GAS unsigned long long*)(H0B + (size_t)pr * D) + F.lane;
        if (t < NPADR) {
#pragma unroll
            for (int j = 0; j < 4; ++j) o8[64 * j] = 0ull;
            continue;
        }
        const float* xrow = (t < 64) ? a.meta + (size_t)(t - NPADR) * D : a.x + ((size_t)bb * SEQ + (t - 64)) * D;
        const GAS f32x4* xr = (const GAS f32x4*)xrow + F.lane;
        f32x4 v[4]; float s = 0.f;
#pragma unroll
        for (int j = 0; j < 4; ++j) { v[j] = __builtin_nontemporal_load(xr + 64 * j); s += (v[j].x + v[j].y) + (v[j].z + v[j].w); }
        const float mean = wave_sum(s) * (1.f / D); float s2 = 0.f;
#pragma unroll
        for (int j = 0; j < 4; ++j) { v[j] = v[j] - mean; s2 += (v[j].x * v[j].x + v[j].y * v[j].y) + (v[j].z * v[j].z + v[j].w * v[j].w); }
        const float rstd = 1.f / sqrtf(wave_sum(s2) * (1.f / D) + LN_EPS);
#pragma unroll
        for (int j = 0; j < 4; ++j) {
            const f32x4 gv = ((const GAS f32x4*)a.g)[F.lane + 64 * j], bv = ((const GAS f32x4*)a.b)[F.lane + 64 * j];
            const f32x4 o = v[j] * rstd * gv + bv;
            o8[64 * j] = (unsigned long long)pk2(o.x, o.y) | ((unsigned long long)pk2(o.z, o.w) << 32);
        }
        if (t >= 64 && F.lane == 0) { STATS[((size_t)bb * SEQ + (t - 64)) * 2] = mean; STATS[((size_t)bb * SEQ + (t - 64)) * 2 + 1] = rstd; }
    }
    float* ROPE = (float*)(ws + WS_ROPE); float* LBT = (float*)(ws + WS_LB);
    const int gt = F.vcu * NWAVES * 64 + F.tid, NGT = F.G * NWAVES * 64;
    for (int i = gt; i < LPAD * 32; i += NGT) {
        const int t = i >> 5, j = i & 31; const int pos = t < NPADR ? 0 : t - NPADR;
        const float inv = 1.0f / powf(10000.0f, (float)(2 * j) / 64.0f);
        const float ang = (float)pos * inv;
        ROPE[2 * i] = cosf(ang); ROPE[2 * i + 1] = sinf(ang);
    }
    { unsigned short* WRH = (unsigned short*)(ws + WS_WRT);
      for (int i = gt; i < NE * D; i += NGT) { const int e = i >> 10, d = i & 1023; const float v = a.w_router[d * NE + e];
          const unsigned h = f2bf(v); WRH[e * 2048 + d] = (unsigned short)h; WRH[e * 2048 + 1024 + d] = (unsigned short)f2bf(v - __builtin_bit_cast(float, h << 16)); } }
    for (int i = gt; i < 512; i += NGT) {
        const float t0 = a.lbt[i], t1 = a.lbt[512 + i]; const float mx = fmaxf(t0, t1); const float e0 = expf(t0 - mx), e1 = expf(t1 - mx);
        LBT[i] = e0 / (e0 + e1);
    }
}

namespace att {
typedef short s16x4 __attribute__((ext_vector_type(4)));
typedef short v4i16_t __attribute__((ext_vector_type(4)));
typedef unsigned u32x2 __attribute__((ext_vector_type(2)));
constexpr int ROWB = 288, TILEB = 64 * ROWB;
__device__ __forceinline__ s16x4 vtr(const LAS unsigned char* p) { return __builtin_bit_cast(s16x4, __builtin_amdgcn_ds_read_tr16_b64_v4i16((LAS v4i16_t*)p)); }
__device__ __forceinline__ unsigned cvtpk(float lo, float hi) { unsigned r; asm volatile("v_cvt_pk_bf16_f32 %0, %1, %2" : "=v"(r) : "v"(lo), "v"(hi)); return r; }
#define MFMA16(a, b, c) __builtin_amdgcn_mfma_f32_16x16x32_bf16((a), (b), (c), 0, 0, 0)

__device__ __forceinline__ void attn_tile(const LAS unsigned char* Kb, const LAS unsigned char* Vb, const bf16x8 (&qf)[2][2], f32x4 (&o1)[8], f32x4 (&o2)[8], f32x4& l1, f32x4& l2, bool first, int r16, int quad) {
    const f32x4 z = {0.f, 0.f, 0.f, 0.f};
    const LAS unsigned char* kp = Kb + r16 * ROWB + quad * 16;
    const LAS unsigned char* vp = Vb + (4 * quad + (r16 >> 2)) * ROWB + (r16 & 3) * 8;
    bf16x8 kf[4][4];
#pragma unroll
    for (int kb = 0; kb < 4; ++kb)
#pragma unroll
        for (int t = 0; t < 4; ++t) kf[kb][t] = *(const LAS bf16x8*)(kp + kb * 16 * ROWB + t * 64);
    s16x4 vlo[4][2], vhi[4][2];
#pragma unroll
    for (int db = 0; db < 4; ++db)
#pragma unroll
        for (int s = 0; s < 2; ++s) { vlo[db][s] = vtr(vp + (32 * s) * ROWB + db * 32); vhi[db][s] = vtr(vp + (32 * s + 16) * ROWB + db * 32); }
    __builtin_amdgcn_sched_barrier(0);
    f32x4 s1[4], s2[4];
#pragma unroll
    for (int kb = 0; kb < 4; ++kb) {
        s1[kb] = MFMA16(kf[kb][0], qf[0][0], z); s1[kb] = MFMA16(kf[kb][1], qf[0][1], s1[kb]);
        s2[kb] = MFMA16(kf[kb][2], qf[1][0], z); s2[kb] = MFMA16(kf[kb][3], qf[1][1], s2[kb]);
    }
#pragma unroll
    for (int kb = 0; kb < 4; ++kb)
#pragma unroll
        for (int j = 0; j < 4; ++j) { s1[kb][j] = __builtin_amdgcn_exp2f(s1[kb][j]); s2[kb][j] = __builtin_amdgcn_exp2f(s2[kb][j]); }
    if (first) {
#pragma unroll
        for (int kb = 0; kb < 3; ++kb) { s1[kb] = z; s2[kb] = z; }
    }
    bf16x8 p1[2], p2[2];
#pragma unroll
    for (int s = 0; s < 2; ++s) {
        v4u a, b;
        a.x = cvtpk(s1[2 * s][0], s1[2 * s][1]); a.y = cvtpk(s1[2 * s][2], s1[2 * s][3]); a.z = cvtpk(s1[2 * s + 1][0], s1[2 * s + 1][1]); a.w = cvtpk(s1[2 * s + 1][2], s1[2 * s + 1][3]);
        b.x = cvtpk(s2[2 * s][0], s2[2 * s][1]); b.y = cvtpk(s2[2 * s][2], s2[2 * s][3]); b.z = cvtpk(s2[2 * s + 1][0], s2[2 * s + 1][1]); b.w = cvtpk(s2[2 * s + 1][2], s2[2 * s + 1][3]);
        p1[s] = __builtin_bit_cast(bf16x8, a); p2[s] = __builtin_bit_cast(bf16x8, b);
    }
    { const bf16x8 ones = {0x3F80, 0x3F80, 0x3F80, 0x3F80, 0x3F80, 0x3F80, 0x3F80, 0x3F80};
      l1 = MFMA16(ones, p1[0], l1); l2 = MFMA16(ones, p2[0], l2); l1 = MFMA16(ones, p1[1], l1); l2 = MFMA16(ones, p2[1], l2); }
    __builtin_amdgcn_sched_barrier(0);
    s16x4 wlo[4][2], whi[4][2];
#pragma unroll
    for (int db = 0; db < 4; ++db)
#pragma unroll
        for (int s = 0; s < 2; ++s) { wlo[db][s] = vtr(vp + (32 * s) * ROWB + (db + 4) * 32); whi[db][s] = vtr(vp + (32 * s + 16) * ROWB + (db + 4) * 32); }
    __builtin_amdgcn_sched_barrier(0);
#pragma unroll
    for (int db = 0; db < 4; ++db)
#pragma unroll
        for (int s = 0; s < 2; ++s) { const bf16x8 vf = __builtin_shufflevector(vlo[db][s], vhi[db][s], 0, 1, 2, 3, 4, 5, 6, 7); o1[db] = MFMA16(vf, p1[s], o1[db]); o2[db] = MFMA16(vf, p2[s], o2[db]); }
    __builtin_amdgcn_sched_barrier(0);
#pragma unroll
    for (int db = 0; db < 4; ++db)
#pragma unroll
        for (int s = 0; s < 2; ++s) { const bf16x8 vf = __builtin_shufflevector(wlo[db][s], whi[db][s], 0, 1, 2, 3, 4, 5, 6, 7); o1[db + 4] = MFMA16(vf, p1[s], o1[db + 4]); o2[db + 4] = MFMA16(vf, p2[s], o2[db + 4]); }
}

__device__ __forceinline__ void attn_unit(const Frame& F, int b, int h, int i, const bf16* QA, const bf16* KA, const bf16* VA, bf16* Y, float lam, const float* subg) {
    int tid = F.tid; asm volatile("" : "+v"(tid));
    const int lane = tid & 63, w = F.wave, r16 = lane & 15, quad = lane >> 4;
    const size_t rowbase = (size_t)b * LPAD;
    const int qrow = 64 + 128 * i + 16 * w + r16;
    bf16x8 qf[2][2];
#pragma unroll
    for (int sub = 0; sub < 2; ++sub)
#pragma unroll
        for (int s = 0; s < 2; ++s) qf[sub][s] = __builtin_nontemporal_load((const GAS bf16x8*)(QA + (rowbase + qrow) * 512 + h * 128 + sub * 64 + s * 32 + quad * 8));
    f32x4 o1[8], o2[8];
#pragma unroll
    for (int db = 0; db < 8; ++db) { o1[db] = (f32x4){0.f, 0.f, 0.f, 0.f}; o2[db] = (f32x4){0.f, 0.f, 0.f, 0.f}; }
    f32x4 l1 = {0.f, 0.f, 0.f, 0.f}, l2 = {0.f, 0.f, 0.f, 0.f};
    const int nt = 2 * i + 3, mytiles = 2 * i + 2 + (w >> 2);
    LAS unsigned char* lds = F.lds + RING_OFF;
    const int srow0 = tid >> 4, sch = tid & 15;
    const bf16* kg = KA + (rowbase + srow0) * 512 + h * 128 + sch * 8;
    const bf16* vg = VA + (rowbase + srow0) * 512 + h * 128 + sch * 8;
    const int soff = srow0 * ROWB + sch * 16;
    v4u kr0, kr1, vr0, vr1;
    kr0 = *(const GAS v4u*)(kg); kr1 = *(const GAS v4u*)(kg + 32 * 512); vr0 = *(const GAS v4u*)(vg); vr1 = *(const GAS v4u*)(vg + 32 * 512);
    *(LAS v4u*)(lds + soff) = kr0; *(LAS v4u*)(lds + soff + 32 * ROWB) = kr1; *(LAS v4u*)(lds + TILEB + soff) = vr0; *(LAS v4u*)(lds + TILEB + soff + 32 * ROWB) = vr1;
    __syncthreads();
    for (int kt = 0; kt < nt; ++kt) {
        const bool more = kt + 1 < nt;
        if (more) { const size_t go = (size_t)(kt + 1) * 64 * 512;
            kr0 = *(const GAS v4u*)(kg + go); kr1 = *(const GAS v4u*)(kg + go + 32 * 512); vr0 = *(const GAS v4u*)(vg + go); vr1 = *(const GAS v4u*)(vg + go + 32 * 512); }
        const LAS unsigned char* Kb = lds + (kt & 1) * 2 * TILEB;
        if (kt < mytiles) attn_tile(Kb, Kb + TILEB, qf, o1, o2, l1, l2, kt == 0, r16, quad);
        if (more) { LAS unsigned char* nb = lds + ((kt + 1) & 1) * 2 * TILEB;
            *(LAS v4u*)(nb + soff) = kr0; *(LAS v4u*)(nb + soff + 32 * ROWB) = kr1; *(LAS v4u*)(nb + TILEB + soff) = vr0; *(LAS v4u*)(nb + TILEB + soff + 32 * ROWB) = vr1; }
        __syncthreads();
    }
    const float i1 = 1.0f / l1[0], i2 = lam / l2[0];
    float ss = 0.f;
#pragma unroll
    for (int db = 0; db < 8; ++db)
#pragma unroll
        for (int j = 0; j < 4; ++j) { const float o = o1[db][j] * i1 - o2[db][j] * i2; o1[db][j] = o; ss += o * o; }
    ss += __shfl_xor(ss, 16); ss += __shfl_xor(ss, 32);
    const float rn = (1.0f - LAM_INIT) / sqrtf(ss * (1.0f / 128.0f) + RMS_EPS);
    bf16* yo = Y + (rowbase + qrow) * 1024 + h * 128 + 4 * quad;
#pragma unroll
    for (int db = 0; db < 8; ++db) {
        const f32x4 g4 = *(const GAS f32x4*)(subg + db * 16 + 4 * quad);
        u32x2 wv; wv.x = cvtpk(o1[db][0] * rn * g4[0], o1[db][1] * rn * g4[1]); wv.y = cvtpk(o1[db][2] * rn * g4[2], o1[db][3] * rn * g4[3]);
        *(GAS u32x2*)(yo + db * 16) = wv;
    }
}
}

namespace hg {
using att::s16x4; using att::u32x2; using att::vtr; using att::cvtpk;
typedef float f32x2 __attribute__((ext_vector_type(2)));
constexpr int ROWB = 288, KTROW = 160, NUNIT = 32 * 33;
constexpr int QT = 0, KT = 18432, VT = 36864, KTT = 55296, Q2 = 55296, SH = 75776, TOT = 112640, EV = 120832, RMSP = 122368;
static_assert(RMSP + 1024 <= RING_BYTES, "hgrn LDS map");
__device__ __forceinline__ int dkperm(int dk) { const int d = dk & 31; return (dk & ~31) | (((d >> 2) & 3) << 3) | ((d >> 4) << 2) | (d & 3); }

__device__ __forceinline__ void hg_arrive(const Frame& F, gu32* ctr) {
    asm volatile("s_waitcnt vmcnt(0)" ::: "memory");
    __syncthreads();
    if (F.tid == 0) __hip_atomic_fetch_add(ctr, 1u, RLX_AGENT);
}
__device__ __forceinline__ void hg_wait(const Frame& F, gu32* ctr, unsigned target) {
    if (F.tid == 0) { unsigned sp = 0; while (__hip_atomic_load(ctr, RLX_AGENT) < target && ++sp < (1u << 22)) __builtin_amdgcn_s_sleep(2); }
    __syncthreads();
}
__device__ __forceinline__ void hgA_unit(const Frame& F0, int u, int par, const float* LF, const bf16* VB, bf16* UH, float* EL, gu32* ctr) {
    Frame F = F0; asm volatile("" : "+v"(F.tid)); F.lane = F.tid & 63;
    const int tid = F.tid, lane = F.lane, w = F.wave, r16 = lane & 15, quad = lane >> 4;
    LAS unsigned char* lds = F.lds + RING_OFF;
    const int bh = u / 33, c = u - bh * 33;
    const size_t r0 = (size_t)(bh >> 2) * LPAD + (size_t)c * 64; const int colh = (bh & 3) * 128;
    const f32x4 z4 = {0.f, 0.f, 0.f, 0.f};
    f32x2 lf[8]; v4u vv0, vv1;
    const int srow0 = tid >> 4, sch = tid & 15;
#pragma unroll
    for (int e = 0; e < 8; ++e) lf[e] = __builtin_nontemporal_load((const GAS f32x2*)(LF + (r0 + 8 * w + e) * 512 + colh + 2 * lane));
    vv0 = __builtin_nontemporal_load((const GAS v4u*)(VB + (r0 + srow0) * 512 + colh + sch * 8)); vv1 = __builtin_nontemporal_load((const GAS v4u*)(VB + (r0 + srow0 + 32) * 512 + colh + sch * 8));
    LAS float* tot = (LAS float*)(lds + TOT + par * 4096);
    f32x2 bc[8]; f32x2 run = {0.f, 0.f};
#pragma unroll
    for (int e = 0; e < 8; ++e) { if (c == 0 && 8 * w + e < NPADR) lf[e] = (f32x2){0.f, 0.f}; run = run + lf[e]; bc[e] = run; }
    *(LAS f32x2*)(tot + w * 128 + 2 * lane) = run;
    __syncthreads();
    f32x2 off = {0.f, 0.f}, bmid = {0.f, 0.f}, blast = {0.f, 0.f};
#pragma unroll
    for (int ww = 0; ww < 8; ++ww) { const f32x2 t = *(const LAS f32x2*)(tot + ww * 128 + 2 * lane); if (ww < w) off = off + t; if (ww < 4) bmid = bmid + t; blast = blast + t; }
    unsigned kk0[8], kk1[8];
#pragma unroll
    for (int e = 0; e < 8; ++e) {
        const f32x2 bb = off + bc[e] - bmid;
        const float e0 = __builtin_amdgcn_exp2f(fminf(fmaxf(bb.x, -120.f), 120.f)), e1 = __builtin_amdgcn_exp2f(fminf(fmaxf(bb.y, -120.f), 120.f));
        const float k0 = (1.0f - __builtin_amdgcn_exp2f(lf[e].x)) * __builtin_amdgcn_rcpf(e0), k1 = (1.0f - __builtin_amdgcn_exp2f(lf[e].y)) * __builtin_amdgcn_rcpf(e1);
        const unsigned kp = cvtpk(k0, k1);
        kk0[e] = kp & 0xffffu; kk1[e] = kp >> 16;
    }
    {
        const int w4 = w & 3, sp = w >> 2;
        const int pos0 = ((2 * w4) & 3) * 8 + (w4 >> 1) * 4, pos1 = ((2 * w4 + 1) & 3) * 8 + (w4 >> 1) * 4;
        LAS unsigned char* q0 = lds + KTT + (2 * lane) * KTROW + sp * 64, *q1 = q0 + KTROW;
        u32x2 a; a.x = kk0[0] | (kk0[1] << 16); a.y = kk0[2] | (kk0[3] << 16); *(LAS u32x2*)(q0 + pos0 * 2) = a;
        a.x = kk0[4] | (kk0[5] << 16); a.y = kk0[6] | (kk0[7] << 16); *(LAS u32x2*)(q0 + pos1 * 2) = a;
        a.x = kk1[0] | (kk1[1] << 16); a.y = kk1[2] | (kk1[3] << 16); *(LAS u32x2*)(q1 + pos0 * 2) = a;
        a.x = kk1[4] | (kk1[5] << 16); a.y = kk1[6] | (kk1[7] << 16); *(LAS u32x2*)(q1 + pos1 * 2) = a;
    }
    *(LAS v4u*)(lds + VT + srow0 * ROWB + sch * 16) = vv0; *(LAS v4u*)(lds + VT + (srow0 + 32) * ROWB + sch * 16) = vv1;
    if (w == 0) {
        LAS float* ev = (LAS float*)(lds + EV);
        *(LAS f32x2*)(ev + 2 * lane) = (f32x2){__builtin_amdgcn_exp2f(fmaxf(blast.x - bmid.x, -120.f)), __builtin_amdgcn_exp2f(fmaxf(blast.y - bmid.y, -120.f))};
        __hip_atomic_store((gu64*)(EL + (size_t)u * 128 + 2 * lane), (unsigned long long)__float_as_uint(__builtin_amdgcn_exp2f(fmaxf(blast.x, -120.f))) | ((unsigned long long)__float_as_uint(__builtin_amdgcn_exp2f(fmaxf(blast.y, -120.f))) << 32), RLX_AGENT);
    }
    __syncthreads();
    const LAS unsigned char* vpw = lds + VT + (4 * quad + (r16 >> 2)) * ROWB + (r16 & 3) * 8 + w * 32;
    const s16x4 lo0 = vtr(vpw), hi0 = vtr(vpw + 16 * ROWB), lo1 = vtr(vpw + 32 * ROWB), hi1 = vtr(vpw + 48 * ROWB);
    const bf16x8 v0 = __builtin_shufflevector(lo0, hi0, 0, 1, 2, 3, 4, 5, 6, 7), v1 = __builtin_shufflevector(lo1, hi1, 0, 1, 2, 3, 4, 5, 6, 7);
    const LAS unsigned char* ktp = lds + KTT + r16 * KTROW + quad * 16;
    const LAS float* ev = (const LAS float*)(lds + EV);
    bf16x8 tf[8][2]; float elm[8];
#pragma unroll
    for (int nb = 0; nb < 8; ++nb) { tf[nb][0] = *(const LAS bf16x8*)(ktp + nb * 16 * KTROW); tf[nb][1] = *(const LAS bf16x8*)(ktp + nb * 16 * KTROW + 64); elm[nb] = ev[nb * 16 + r16]; }
    gu64* uo = (gu64*)(UH + ((size_t)u * 8 + w) * 2048) + lane;
#pragma unroll
    for (int nb = 0; nb < 8; ++nb) { f32x4 uu = MFMA16(v0, tf[nb][0], z4); uu = MFMA16(v1, tf[nb][1], uu); uu = uu * elm[nb];
        __hip_atomic_store(uo + nb * 64, (unsigned long long)cvtpk(uu[0], uu[1]) | ((unsigned long long)cvtpk(uu[2], uu[3]) << 32), RLX_AGENT); }
    hg_arrive(F, ctr);
}

__device__ __forceinline__ void hg_scan_job(int job, int lane, const bf16* UH, const float* EL, bf16* SP) {
    const int bh = job >> 6, w = (job >> 3) & 7, nb = job & 7, r16 = lane & 15;
    f32x4 S = {0.f, 0.f, 0.f, 0.f};
    const size_t ubase = (size_t)bh * 33;
    unsigned long long ub[33]; unsigned el[33];
#pragma unroll
    for (int c = 0; c < 33; ++c) {
        ub[c] = __hip_atomic_load((gu64*)(UH + ((ubase + c) * 8 + w) * 2048 + nb * 256 + lane * 4), RLX_AGENT);
        el[c] = __hip_atomic_load((gu32*)(EL + (ubase + c) * 128 + nb * 16 + r16), RLX_AGENT);
    }
#pragma unroll
    for (int c = 0; c < 33; ++c) {
        const f32x4 uh = {__uint_as_float((unsigned)ub[c] << 16), __uint_as_float((unsigned)ub[c] & 0xffff0000u), __uint_as_float((unsigned)(ub[c] >> 32) << 16), __uint_as_float((unsigned)(ub[c] >> 32) & 0xffff0000u)};
        __hip_atomic_store((gu64*)(SP + ((ubase + c) * 8 + w) * 2048 + nb * 256 + lane * 4), (unsigned long long)cvtpk(S[0], S[1]) | ((unsigned long long)cvtpk(S[2], S[3]) << 32), RLX_AGENT);
        S = S * __uint_as_float(el[c]) + uh;
    }
}

__device__ __forceinline__ void hgC_unit(const Frame& F0, int u, int par, const bf16* QB, const float* LF, const bf16* VB, const bf16* GB, const bf16* SP, bf16* Y, const float* norm_g, gu32* ctr) {
    Frame F = F0; asm volatile("" : "+v"(F.tid)); F.lane = F.tid & 63;
    const int tid = F.tid, lane = F.lane, w = F.wave, r16 = lane & 15, quad = lane >> 4;
    LAS unsigned char* lds = F.lds + RING_OFF;
    const int bh = u / 33, c = u - bh * 33;
    const size_t r0 = (size_t)(bh >> 2) * LPAD + (size_t)c * 64; const int colh = (bh & 3) * 128;
    const f32x4 z4 = {0.f, 0.f, 0.f, 0.f};
    const int srow0 = tid >> 4, sch = tid & 15;
    const int tb = w & 3, dh = w >> 2;
    f32x2 lf[8]; unsigned qb[8]; v4u vv0, vv1; u32x2 sp8[8], gbv[4];
#pragma unroll
    for (int e = 0; e < 8; ++e) { const size_t o = (r0 + 8 * w + e) * 512 + colh + 2 * lane; lf[e] = __builtin_nontemporal_load((const GAS f32x2*)(LF + o)); qb[e] = __builtin_nontemporal_load((const GAS unsigned*)(QB + o)); }
    vv0 = __builtin_nontemporal_load((const GAS v4u*)(VB + (r0 + srow0) * 512 + colh + sch * 8)); vv1 = __builtin_nontemporal_load((const GAS v4u*)(VB + (r0 + srow0 + 32) * 512 + colh + sch * 8));
    hg_wait(F, ctr, 8u);
    { gu64* sp = (gu64*)(SP + ((size_t)u * 8 + w) * 2048) + lane;
#pragma unroll
      for (int nb = 0; nb < 8; ++nb) { const unsigned long long a0 = __hip_atomic_load(sp + nb * 64, RLX_AGENT); sp8[nb] = (u32x2){(unsigned)a0, (unsigned)(a0 >> 32)}; } }
    const size_t orow = r0 + tb * 16 + r16;
#pragma unroll
    for (int d = 0; d < 4; ++d) gbv[d] = __builtin_nontemporal_load((const GAS u32x2*)(GB + orow * 512 + colh + (dh * 4 + d) * 16 + 4 * quad));
    LAS float* tot = (LAS float*)(lds + TOT + par * 4096);
    f32x2 bc[8]; f32x2 run = {0.f, 0.f};
#pragma unroll
    for (int e = 0; e < 8; ++e) { if (c == 0 && 8 * w + e < NPADR) lf[e] = (f32x2){0.f, 0.f}; run = run + lf[e]; bc[e] = run; }
    *(LAS f32x2*)(tot + w * 128 + 2 * lane) = run;
    __syncthreads();
    f32x2 off = {0.f, 0.f}, bmid = {0.f, 0.f};
#pragma unroll
    for (int ww = 0; ww < 8; ++ww) { const f32x2 t = *(const LAS f32x2*)(tot + ww * 128 + 2 * lane); if (ww < w) off = off + t; if (ww < 4) bmid = bmid + t; }
    const f32x2 em = {__builtin_amdgcn_exp2f(fmaxf(bmid.x, -120.f)), __builtin_amdgcn_exp2f(fmaxf(bmid.y, -120.f))};
    const int pcol = dkperm(2 * lane) * 2;
#pragma unroll
    for (int e = 0; e < 8; ++e) {
        const f32x2 bb = off + bc[e] - bmid;
        const float e0 = __builtin_amdgcn_exp2f(fminf(fmaxf(bb.x, -120.f), 120.f)), e1 = __builtin_amdgcn_exp2f(fminf(fmaxf(bb.y, -120.f), 120.f));
        const float q0 = __uint_as_float(qb[e] << 16) * e0, q1 = __uint_as_float(qb[e] & 0xffff0000u) * e1;
        const float k0 = (1.0f - __builtin_amdgcn_exp2f(lf[e].x)) * __builtin_amdgcn_rcpf(e0), k1 = (1.0f - __builtin_amdgcn_exp2f(lf[e].y)) * __builtin_amdgcn_rcpf(e1);
        *(LAS unsigned*)(lds + QT + (8 * w + e) * ROWB + pcol) = cvtpk(q0, q1);
        *(LAS unsigned*)(lds + Q2 + (8 * w + e) * ROWB + pcol) = cvtpk(q0 * em.x, q1 * em.y);
        *(LAS unsigned*)(lds + KT + (8 * w + e) * ROWB + pcol) = cvtpk(k0, k1);
    }
    *(LAS v4u*)(lds + VT + srow0 * ROWB + sch * 16) = vv0; *(LAS v4u*)(lds + VT + (srow0 + 32) * ROWB + sch * 16) = vv1;
#pragma unroll
    for (int nb = 0; nb < 8; ++nb) {
        *(LAS u32x2*)(lds + SH + (nb * 16 + r16) * ROWB + (16 * w + 4 * quad) * 2) = sp8[nb];
    }
    __syncthreads();
    const int troff = (4 * quad + (r16 >> 2)) * ROWB + (r16 & 3) * 8;
    const LAS unsigned char* vp = lds + VT + troff;
    const LAS unsigned char* shp = lds + SH + troff + dh * 128;
    const LAS unsigned char* qp = lds + QT + (tb * 16 + r16) * ROWB + quad * 16;
    const LAS unsigned char* q2p = lds + Q2 + (tb * 16 + r16) * ROWB + quad * 16;
    const LAS unsigned char* kp0 = lds + KT + r16 * ROWB + quad * 16;
    bf16x8 qf[4], kf[2][4];
#pragma unroll
    for (int ks = 0; ks < 4; ++ks) qf[ks] = *(const LAS bf16x8*)(qp + ks * 64);
#pragma unroll
    for (int sb = 0; sb < 2; ++sb)
#pragma unroll
        for (int ks = 0; ks < 4; ++ks) kf[sb][ks] = *(const LAS bf16x8*)(kp0 + sb * 16 * ROWB + ks * 64);
    s16x4 vlo[4][2], vhi[4][2];
#pragma unroll
    for (int d = 0; d < 4; ++d)
#pragma unroll
        for (int s2 = 0; s2 < 2; ++s2) { vlo[d][s2] = vtr(vp + (32 * s2) * ROWB + (dh * 4 + d) * 32); vhi[d][s2] = vtr(vp + (32 * s2 + 16) * ROWB + (dh * 4 + d) * 32); }
    __builtin_amdgcn_sched_barrier(0);
    f32x4 pt[4];
#pragma unroll
    for (int sb = 0; sb < 2; ++sb) {
        pt[sb] = z4;
#pragma unroll
        for (int ks = 0; ks < 4; ++ks) pt[sb] = MFMA16(kf[sb][ks], qf[ks], pt[sb]);
    }
    __builtin_amdgcn_sched_barrier(0);
#pragma unroll
    for (int sb = 0; sb < 2; ++sb)
#pragma unroll
        for (int ks = 0; ks < 4; ++ks) kf[sb][ks] = *(const LAS bf16x8*)(kp0 + (sb + 2) * 16 * ROWB + ks * 64);
    __builtin_amdgcn_sched_barrier(0);
#pragma unroll
    for (int sb = 0; sb < 2; ++sb) {
        pt[sb + 2] = z4;
#pragma unroll
        for (int ks = 0; ks < 4; ++ks) pt[sb + 2] = MFMA16(kf[sb][ks], qf[ks], pt[sb + 2]);
    }
    __builtin_amdgcn_sched_barrier(0);
#pragma unroll
    for (int ks = 0; ks < 4; ++ks) qf[ks] = *(const LAS bf16x8*)(q2p + ks * 64);
    s16x4 slo[2][4], shi[2][4];
#pragma unroll
    for (int d = 0; d < 2; ++d)
#pragma unroll
        for (int ks = 0; ks < 4; ++ks) { slo[d][ks] = vtr(shp + (32 * ks) * ROWB + d * 32); shi[d][ks] = vtr(shp + (32 * ks + 16) * ROWB + d * 32); }
    __builtin_amdgcn_sched_barrier(0);
#pragma unroll
    for (int sb = 0; sb < 4; ++sb)
#pragma unroll
        for (int j = 0; j < 4; ++j) { const bool keep = (sb < tb) || (sb == tb && 4 * quad + j <= r16); pt[sb][j] = keep ? pt[sb][j] : 0.f; }
    bf16x8 pf[2];
#pragma unroll
    for (int s2 = 0; s2 < 2; ++s2) { v4u a; a.x = cvtpk(pt[2 * s2][0], pt[2 * s2][1]); a.y = cvtpk(pt[2 * s2][2], pt[2 * s2][3]); a.z = cvtpk(pt[2 * s2 + 1][0], pt[2 * s2 + 1][1]); a.w = cvtpk(pt[2 * s2 + 1][2], pt[2 * s2 + 1][3]);
        pf[s2] = __builtin_bit_cast(bf16x8, a); }
    f32x4 o[4];
#pragma unroll
    for (int d = 0; d < 4; ++d) {
        o[d] = MFMA16(__builtin_shufflevector(vlo[d][0], vhi[d][0], 0, 1, 2, 3, 4, 5, 6, 7), pf[0], z4);
        o[d] = MFMA16(__builtin_shufflevector(vlo[d][1], vhi[d][1], 0, 1, 2, 3, 4, 5, 6, 7), pf[1], o[d]);
    }
#pragma unroll
    for (int d = 0; d < 2; ++d)
#pragma unroll
        for (int ks = 0; ks < 4; ++ks) o[d] = MFMA16(__builtin_shufflevector(slo[d][ks], shi[d][ks], 0, 1, 2, 3, 4, 5, 6, 7), qf[ks], o[d]);
    __builtin_amdgcn_sched_barrier(0);
#pragma unroll
    for (int d = 0; d < 2; ++d)
#pragma unroll
        for (int ks = 0; ks < 4; ++ks) { slo[d][ks] = vtr(shp + (32 * ks) * ROWB + (d + 2) * 32); shi[d][ks] = vtr(shp + (32 * ks + 16) * ROWB + (d + 2) * 32); }
    __builtin_amdgcn_sched_barrier(0);
#pragma unroll
    for (int d = 0; d < 2; ++d)
#pragma unroll
        for (int ks = 0; ks < 4; ++ks) o[d + 2] = MFMA16(__builtin_shufflevector(slo[d][ks], shi[d][ks], 0, 1, 2, 3, 4, 5, 6, 7), qf[ks], o[d + 2]);
    float ss = 0.f;
#pragma unroll
    for (int d = 0; d < 4; ++d) ss += (o[d][0] * o[d][0] + o[d][1] * o[d][1]) + (o[d][2] * o[d][2] + o[d][3] * o[d][3]);
    ss += __shfl_xor(ss, 16); ss += __shfl_xor(ss, 32);
    LAS float* rp = (LAS float*)(lds + RMSP + par * 512);
    if (quad == 0) rp[dh * 64 + tb * 16 + r16] = ss;
    __syncthreads();
    {
        const float ms = (rp[tb * 16 + r16] + rp[64 + tb * 16 + r16]) * (1.0f / 128.0f);
        const float rn = 1.0f / sqrtf(ms + RMS_EPS);
        bf16* yo = Y + orow * 1024 + 512 + colh + 4 * quad;
#pragma unroll
        for (int d = 0; d < 4; ++d) {
            const int db = dh * 4 + d;
            const f32x4 g4 = *(const GAS f32x4*)(norm_g + db * 16 + 4 * quad);
            const float g0 = __uint_as_float(gbv[d].x << 16), g1 = __uint_as_float(gbv[d].x & 0xffff0000u), g2 = __uint_as_float(gbv[d].y << 16), g3 = __uint_as_float(gbv[d].y & 0xffff0000u);
            u32x2 wv; wv.x = cvtpk(o[d][0] * rn * g4[0] * g0, o[d][1] * rn * g4[1] * g1); wv.y = cvtpk(o[d][2] * rn * g4[2] * g2, o[d][3] * rn * g4[3] * g3);
            *(GAS u32x2*)(yo + db * 16) = wv;
        }
    }
}
}

typedef float f32x2 __attribute__((ext_vector_type(2)));
__device__ __forceinline__ void p4_ln_row(f32x4 (&v)[4], const float* ln1g, const float* ln1b, bf16* H1B, float* ST1, int r, int lane) {
    float s = 0.f;
#pragma unroll
    for (int j = 0; j < 4; ++j) s += (v[j].x + v[j].y) + (v[j].z + v[j].w);
    const float mean = wave_sum(s) * (1.f / D); float s2 = 0.f;
#pragma unroll
    for (int j = 0; j < 4; ++j) { v[j] = v[j] - mean; s2 += (v[j].x * v[j].x + v[j].y * v[j].y) + (v[j].z * v[j].z + v[j].w * v[j].w); }
    const float rstd = 1.f / sqrtf(wave_sum(s2) * (1.f / D) + LN_EPS);
    GAS unsigned long long* o8 = (GAS unsigned long long*)(H1B + (size_t)r * D) + lane;
#pragma unroll
    for (int j = 0; j < 4; ++j) { v[j] = v[j] * rstd * ((const GAS f32x4*)ln1g)[lane + 64 * j] + ((const GAS f32x4*)ln1b)[lane + 64 * j];
        if constexpr (FP8_GU) ((GAS unsigned*)((unsigned char*)H1B + (size_t)r * D))[lane + 64 * j] = pg8::pk4_fp8(v[j].x, v[j].y, v[j].z, v[j].w);
        else o8[64 * j] = (unsigned long long)pk2(v[j].x, v[j].y) | ((unsigned long long)pk2(v[j].z, v[j].w) << 32); }
    if (lane == 0) { ST1[2 * r] = mean; ST1[2 * r + 1] = rstd; }
}
__device__ __forceinline__ void p4_route2(float logit, int lane, int r, int tl, float* GATES, LAS int* lcnt, LAS int* sel, LAS float* scr) {
    const int e = lane & 31, h = lane >> 5;
    LAS float* sc = scr + 64 * h;
    sc[e] = logit;
    asm volatile("s_waitcnt lgkmcnt(0)" ::: "memory");
    int rank = 0;
#pragma unroll
    for (int q = 0; q < 8; ++q) {
        const f32x4 o = *(const LAS f32x4*)(sc + 4 * q);
        rank += (o.x > logit || (o.x == logit && 4 * q + 0 < e)) ? 1 : 0; rank += (o.y > logit || (o.y == logit && 4 * q + 1 < e)) ? 1 : 0;
        rank += (o.z > logit || (o.z == logit && 4 * q + 2 < e)) ? 1 : 0; rank += (o.w > logit || (o.w == logit && 4 * q + 3 < e)) ? 1 : 0;
    }
    const bool win = rank < 4;
    if (win) sc[32 + rank] = logit;
    asm volatile("s_waitcnt lgkmcnt(0)" ::: "memory");
    const f32x4 top = *(const LAS f32x4*)(sc + 32);
    const float sume = 1.0f + expf(top.y - top.x) + expf(top.z - top.x) + expf(top.w - top.x);
    if (win) {
        GATES[(r + h) * 4 + rank] = expf(logit - top.x) / sume;
        const int lp = __hip_atomic_fetch_add(lcnt + e, 1, __ATOMIC_RELAXED, __HIP_MEMORY_SCOPE_WORKGROUP);
        sel[(tl + h) * 4 + rank] = (e << 16) | lp;
    }
    asm volatile("s_waitcnt lgkmcnt(0)" ::: "memory");
}
__device__ __forceinline__ void p4_split_row(const f32x4 (&v)[4], LAS unsigned char* AH, LAS unsigned char* AL, int lr, int lane) {
#pragma unroll
    for (int j = 0; j < 4; ++j) {
        const unsigned h0 = pg8::cvt_pk_bf16(v[j].x, v[j].y), h1 = pg8::cvt_pk_bf16(v[j].z, v[j].w);
        const float hx = __builtin_bit_cast(float, h0 << 16), hy = __builtin_bit_cast(float, h0 & 0xffff0000u), hz = __builtin_bit_cast(float, h1 << 16), hw = __builtin_bit_cast(float, h1 & 0xffff0000u);
        const unsigned l0 = pg8::cvt_pk_bf16(v[j].x - hx, v[j].y - hy), l1 = pg8::cvt_pk_bf16(v[j].z - hz, v[j].w - hw);
        const int chunk = (lane >> 1) + 32 * j, addr = lr * 2048 + ((chunk ^ (lr & 15)) << 4) + (lane & 1) * 8;
        *(LAS pg8::u32x2*)(AH + addr) = (pg8::u32x2){h0, h1}; *(LAS pg8::u32x2*)(AL + addr) = (pg8::u32x2){l0, l1};
    }
}
__device__ __forceinline__ void wave_sum4(float (&s)[4]) {
#pragma unroll
    for (int o = 1; o < 64; o <<= 1) { float t[4];
#pragma unroll
        for (int k = 0; k < 4; ++k) t[k] = __shfl_xor(s[k], o);
#pragma unroll
        for (int k = 0; k < 4; ++k) s[k] += t[k]; }
}
__device__ __forceinline__ void p4_ln_rows4(f32x4 (&v)[4][4], const f32x4 (&g)[4], const f32x4 (&b)[4], bf16* H1B, float* ST1, int r0, int lane) {
    float s[4], s2[4];
#pragma unroll
    for (int k = 0; k < 4; ++k) { s[k] = 0.f;
#pragma unroll
        for (int j = 0; j < 4; ++j) s[k] += (v[k][j].x + v[k][j].y) + (v[k][j].z + v[k][j].w); }
    wave_sum4(s);
#pragma unroll
    for (int k = 0; k < 4; ++k) { s[k] *= (1.f / D); s2[k] = 0.f;
#pragma unroll
        for (int j = 0; j < 4; ++j) { v[k][j] = v[k][j] - s[k]; s2[k] += (v[k][j].x * v[k][j].x + v[k][j].y * v[k][j].y) + (v[k][j].z * v[k][j].z + v[k][j].w * v[k][j].w); } }
    wave_sum4(s2);
#pragma unroll
    for (int k = 0; k < 4; ++k) {
        const float rstd = 1.f / sqrtf(s2[k] * (1.f / D) + LN_EPS);
#pragma unroll
        for (int j = 0; j < 4; ++j) { v[k][j] = v[k][j] * rstd * g[j] + b[j];
            ((GAS unsigned*)((unsigned char*)H1B + (size_t)(r0 + k) * D))[lane + 64 * j] = pg8::pk4_fp8(v[k][j].x, v[k][j].y, v[k][j].z, v[k][j].w); }
        if (lane == 0) { ST1[2 * (r0 + k)] = s[k]; ST1[2 * (r0 + k) + 1] = rstd; }
    }
}
__device__ __forceinline__ void p4_router(const Frame& F, unsigned char* ws, const float* ln1g, const float* ln1b, const float* b_router, int cw_cnt) {
    const int tid = F.tid, lane = F.lane, w = F.wave;
    LAS unsigned char* AH = F.lds + RING_OFF; LAS unsigned char* AL = AH + 65536;
    LAS float* part = (LAS float*)(F.lds + LDSCTL_OFF + 8192);
    LAS int* lcnt = (LAS int*)(F.lds + LCNT_OFF); LAS int* gbase = (LAS int*)(F.lds + GBASE_OFF); LAS int* sel = (LAS int*)(F.lds + SEL_OFF);
    const float* PRE1 = (const float*)(ws + WS_PRE1); bf16* H1B = (bf16*)(ws + WS_H1B); float* ST1 = (float*)(ws + WS_ST1);
    float* GATES = (float*)(ws + WS_GATES); int* TSLOT = (int*)(ws + WS_TSLOT); int* LIST = (int*)(ws + WS_LIST);
    int* cnt = (int*)(ws + WS_CTL) + cw_cnt;
    const float brt = b_router[lane & 31];
    LAS float* rscr = (LAS float*)(F.lds + LDSCTL_OFF + 4096 + w * 512);
    const int r16 = lane & 15, quad = lane >> 4, rb = w & 1, eb = (w >> 1) & 1, kh = w >> 2;
    const bf16* bhp0 = (const bf16*)(ws + WS_WRT) + (size_t)(eb * 16 + r16) * 2048 + kh * 512 + quad * 8;
    for (int grp = F.vcu; grp < MR / 64; grp += F.G) {
        if (tid < 32) lcnt[tid] = 0;
        __syncthreads();
#pragma unroll 1
        for (int rd = 0; rd < 2; ++rd) {
            { const int lr = 4 * w, r0 = grp * 64 + rd * 32 + lr;
              f32x4 v[4][4];
#pragma unroll
              for (int k = 0; k < 4; ++k) { const GAS f32x4* xa = (const GAS f32x4*)(PRE1 + (size_t)(r0 + k) * D) + lane;
#pragma unroll
                  for (int j = 0; j < 4; ++j) v[k][j] = __builtin_nontemporal_load(xa + 64 * j); }
              f32x4 g4[4], b4[4];
#pragma unroll
              for (int j = 0; j < 4; ++j) { g4[j] = ((const GAS f32x4*)ln1g)[lane + 64 * j]; b4[j] = ((const GAS f32x4*)ln1b)[lane + 64 * j]; }
              p4_ln_rows4(v, g4, b4, H1B, ST1, r0, lane);
#pragma unroll
              for (int k = 0; k < 4; ++k) p4_split_row(v[k], AH, AL, lr + k, lane);
            }
            { bf16x8 bh[8], bl[8], ch[8], cl[8];
              const bf16* bhp = bhp0; asm volatile("" : "+v"(bhp));
              asm volatile("s_waitcnt lgkmcnt(0)" ::: "memory"); __builtin_amdgcn_sched_barrier(0);
#pragma unroll
              for (int s = 0; s < 8; ++s) { bh[s] = *(const GAS bf16x8*)(bhp + 32 * s); bl[s] = *(const GAS bf16x8*)(bhp + 1024 + 32 * s); }
              __syncthreads();
#pragma unroll
              for (int s = 0; s < 8; ++s) { ch[s] = *(const GAS bf16x8*)(bhp + 256 + 32 * s); cl[s] = *(const GAS bf16x8*)(bhp + 1024 + 256 + 32 * s); }
              __builtin_amdgcn_sched_barrier(0);
              f32x4 acc0 = {0.f, 0.f, 0.f, 0.f}, acc1 = acc0, acc2 = acc0;
              const int arow = rb * 16 + r16;
#pragma unroll
              for (int s = 0; s < 8; ++s) {
                  const int chunk = kh * 64 + 4 * s + quad, aaddr = arow * 2048 + ((chunk ^ r16) << 4);
                  const bf16x8 ah = *(const LAS bf16x8*)(AH + aaddr), al = *(const LAS bf16x8*)(AL + aaddr);
                  acc0 = MFMA16(ah, bh[s], acc0); acc1 = MFMA16(ah, bl[s], acc1); acc2 = MFMA16(al, bh[s], acc2);
              }
#pragma unroll
              for (int s = 0; s < 8; ++s) {
                  const int chunk = kh * 64 + 4 * (s + 8) + quad, aaddr = arow * 2048 + ((chunk ^ r16) << 4);
                  const bf16x8 ah = *(const LAS bf16x8*)(AH + aaddr), al = *(const LAS bf16x8*)(AL + aaddr);
                  acc0 = MFMA16(ah, ch[s], acc0); acc1 = MFMA16(ah, cl[s], acc1); acc2 = MFMA16(al, ch[s], acc2);
              }
#pragma unroll
              for (int v = 0; v < 4; ++v) part[(kh * 32 + rb * 16 + 4 * quad + v) * 32 + eb * 16 + r16] = acc0[v] + (acc1[v] + acc2[v]);
            }
            __syncthreads();
#pragma unroll 1
            for (int i = 0; i < 4; i += 2) {
                const int lr = 4 * w + i, tl = rd * 32 + lr;
                const float logit = part[lr * 32 + lane] + part[1024 + lr * 32 + lane] + brt;
                p4_route2(logit, lane, grp * 64 + tl, tl, GATES, lcnt, sel, rscr);
            }
        }
        __syncthreads();
        if (tid < 32) gbase[tid] = __hip_atomic_fetch_add(cnt + tid, lcnt[tid], RLX_AGENT);
        __syncthreads();
        if (tid < 256) { const int sv = sel[tid], e = sv >> 16, pos = gbase[e] + (sv & 0xffff), r = grp * 64 + (tid >> 2); LIST[e * MR + pos] = r; TSLOT[r * 4 + (tid & 3)] = (e << 16) | pos; }
        __syncthreads();
    }
}

__device__ __forceinline__ void moe_tile_prefix(const Frame& F, unsigned char* ws) {
    if (F.wave == 0) {
        const int* cnt = (const int*)(ws + WS_CTL) + CW_CNT;
        int n = (F.lane < 32) ? (__hip_atomic_load(cnt + (F.lane & 31), RLX_AGENT) + 255) >> 8 : 0;
#pragma unroll
        for (int o = 1; o < 32; o <<= 1) { const int t = __shfl_up(n, o); if ((F.lane & 31) >= o) n += t; }
        LAS int* tpre = (LAS int*)(F.lds + TPRE_OFF);
        if (F.lane < 32) tpre[F.lane + 1] = n;
        if (F.lane == 0) tpre[0] = 0;
    }
    __syncthreads();
}
typedef float f32x2v __attribute__((ext_vector_type(2)));
__device__ __forceinline__ void p0_ln_load4(f32x4 (&v)[4][4], const P0Args& a, int prow, int lane) {
    const int bb = prow / LPAD, t0 = prow % LPAD;
    if (t0 < NPADR) return;
    const float* xrow = (t0 < 64) ? a.meta + (size_t)(t0 - NPADR) * D : a.x + ((size_t)bb * SEQ + (t0 - 64)) * D;
#pragma unroll
    for (int k = 0; k < 4; ++k) { const GAS f32x4* xr = (const GAS f32x4*)(xrow + (size_t)k * D) + lane;
#pragma unroll
        for (int j = 0; j < 4; ++j) v[k][j] = __builtin_nontemporal_load(xr + 64 * j); }
}
__device__ __forceinline__ void p0_ln_producer(const Frame& F, const P0Args& a, unsigned char* ws, int pi) {
    bf16* H0B = (bf16*)(ws + WS_H0B); float* STATS = (float*)(ws + WS_STATS);
    int lane = F.lane; asm volatile("" : "+v"(lane));
    const int pw = pi * NWAVES + F.wave; constexpr int NPW = 8 * P1_NPX * NWAVES;
    f32x4 gv[4], bv[4];
#pragma unroll
    for (int j = 0; j < 4; ++j) { gv[j] = ((const GAS f32x4*)a.g)[lane + 64 * j]; bv[j] = ((const GAS f32x4*)a.b)[lane + 64 * j]; }
    int prow = P1_LN0 + pw * 4;
    if (prow >= MP) return;
    f32x4 v[4][4], vn[4][4];
    p0_ln_load4(v, a, prow, lane);
#pragma unroll 1
    for (;;) {
        const int nrow = prow + NPW * 4; const bool more = nrow < MP;
        if (more) p0_ln_load4(vn, a, nrow, lane);
        const int bb = prow / LPAD, t0 = prow % LPAD;
        gu64* o8 = (gu64*)(H0B + (size_t)prow * D) + lane;
        if (t0 < NPADR) {
#pragma unroll
            for (int k = 0; k < 4; ++k)
#pragma unroll
                for (int j = 0; j < 4; ++j) __hip_atomic_store(o8 + (size_t)k * (D / 4) + 64 * j, 0ull, RLX_AGENT);
        } else {
            float s[4], s2[4];
#pragma unroll
            for (int k = 0; k < 4; ++k) { s[k] = 0.f;
#pragma unroll
                for (int j = 0; j < 4; ++j) s[k] += (v[k][j].x + v[k][j].y) + (v[k][j].z + v[k][j].w); }
            wave_sum4(s);
#pragma unroll
            for (int k = 0; k < 4; ++k) { s[k] *= (1.f / D); s2[k] = 0.f;
#pragma unroll
                for (int j = 0; j < 4; ++j) { v[k][j] = v[k][j] - s[k]; s2[k] += (v[k][j].x * v[k][j].x + v[k][j].y * v[k][j].y) + (v[k][j].z * v[k][j].z + v[k][j].w * v[k][j].w); } }
            wave_sum4(s2);
#pragma unroll
            for (int k = 0; k < 4; ++k) {
                const float rstd = 1.f / sqrtf(s2[k] * (1.f / D) + LN_EPS);
#pragma unroll
                for (int j = 0; j < 4; ++j) { const f32x4 o = v[k][j] * rstd * gv[j] + bv[j];
                    __hip_atomic_store(o8 + (size_t)k * (D / 4) + 64 * j, (unsigned long long)pg8::cvt_pk_bf16(o.x, o.y) | ((unsigned long long)pg8::cvt_pk_bf16(o.z, o.w) << 32), RLX_AGENT); }
                if (t0 >= 64 && lane == 0) { STATS[((size_t)bb * SEQ + (t0 - 64 + k)) * 2] = s[k]; STATS[((size_t)bb * SEQ + (t0 - 64 + k)) * 2 + 1] = rstd; }
            }
        }
        asm volatile("s_waitcnt vmcnt(0)" ::: "memory");
        if (lane == 0) __hip_atomic_fetch_add(F.ctl + CW_LN + 64 * (prow >> 8), 4u, RLX_AGENT);
        if (!more) break;
#pragma unroll
        for (int k = 0; k < 4; ++k)
#pragma unroll
            for (int j = 0; j < 4; ++j) v[k][j] = vn[k][j];
        prow = nrow;
    }
}
struct P7A { f32x4 v[4]; float mu, rs; int sp[4]; float gt[4]; };
struct P7Y { unsigned y[4][4]; };
__device__ __forceinline__ void p7_loadA(P7A& a, int r, int lane, const float* PRE1, const float* ST1, const int* TSLOT, const float* GATES) {
    const GAS f32x4* xr = (const GAS f32x4*)(PRE1 + (size_t)r * D) + lane;
#pragma unroll
    for (int j = 0; j < 4; ++j) a.v[j] = __builtin_nontemporal_load(xr + 64 * j);
    a.mu = ST1[2 * r]; a.rs = ST1[2 * r + 1];
#pragma unroll
    for (int k = 0; k < 4; ++k) { a.sp[k] = TSLOT[r * 4 + k]; a.gt[k] = GATES[r * 4 + k]; }
}
__device__ __forceinline__ void p7_loadY(P7Y& y, const P7A& a, int lane, const unsigned char* YE, const LAS int* tpre) {
#pragma unroll
    for (int k = 0; k < 4; ++k) {
        const int e = a.sp[k] >> 16, pos = a.sp[k] & 0xffff;
        const GAS unsigned* yr = (const GAS unsigned*)(YE + ((size_t)tpre[e] * 256 + pos) * D) + lane;
#pragma unroll
        for (int j = 0; j < 4; ++j) y.y[k][j] = __builtin_nontemporal_load(yr + 64 * j);
    }
}
__device__ __forceinline__ void p7_final(const Frame& F, unsigned char* ws, const float* ln1g, const float* ln1b, const float* ln2g, const float* ln2b, float* out) {
    static_assert(FP8_YE, "p7_final reads fp8 expert outputs");
    const int lane = F.lane;
    const int gw = F.vcu * NWAVES + F.wave, NGW = F.G * NWAVES;
    const float* PRE1 = (const float*)(ws + WS_PRE1); const float* ST1 = (const float*)(ws + WS_ST1);
    const float* GATES = (const float*)(ws + WS_GATES); const int* TSLOT = (const int*)(ws + WS_TSLOT); const unsigned char* YE = (const unsigned char*)(ws + WS_YE);
    const LAS int* tpre = (const LAS int*)(F.lds + TPRE_OFF);
    P7A a0, a1, a2; P7Y y0, y1;
    if (gw < MR) { p7_loadA(a0, gw, lane, PRE1, ST1, TSLOT, GATES); p7_loadY(y0, a0, lane, YE, tpre); }
    if (gw + NGW < MR) p7_loadA(a1, gw + NGW, lane, PRE1, ST1, TSLOT, GATES);
    for (int r = gw; r < MR; r += NGW) {
        if (r + 2 * NGW < MR) p7_loadA(a2, r + 2 * NGW, lane, PRE1, ST1, TSLOT, GATES);
        if (r + NGW < MR) p7_loadY(y1, a1, lane, YE, tpre);
        f32x4 v[4];
#pragma unroll
        for (int j = 0; j < 4; ++j) { const f32x4 gv = ((const GAS f32x4*)ln1g)[lane + 64 * j], bv = ((const GAS f32x4*)ln1b)[lane + 64 * j]; v[j] = ((a0.v[j] - a0.mu) * a0.rs * gv + bv) * ALPHA; }
#pragma unroll
        for (int k = 0; k < 4; ++k) {
            const float g8 = a0.gt[k] * (1.0f / YE_SCALE);
#pragma unroll
            for (int j = 0; j < 4; ++j) { const int y = (int)y0.y[k][j]; const f32x2v lo = __builtin_amdgcn_cvt_pk_f32_fp8(y, false), hi = __builtin_amdgcn_cvt_pk_f32_fp8(y, true);
                v[j].x += g8 * lo.x; v[j].y += g8 * lo.y; v[j].z += g8 * hi.x; v[j].w += g8 * hi.y; }
        }
        float s = 0.f;
#pragma unroll
        for (int j = 0; j < 4; ++j) s += (v[j].x + v[j].y) + (v[j].z + v[j].w);
        const float mean = wave_sum(s) * (1.f / D); float s2 = 0.f;
#pragma unroll
        for (int j = 0; j < 4; ++j) { v[j] = v[j] - mean; s2 += (v[j].x * v[j].x + v[j].y * v[j].y) + (v[j].z * v[j].z + v[j].w * v[j].w); }
        const float rstd = 1.f / sqrtf(wave_sum(s2) * (1.f / D) + LN_EPS);
        GAS f32x4* orow = (GAS f32x4*)(out + (size_t)r * D) + lane;
#pragma unroll
        for (int j = 0; j < 4; ++j) { const f32x4 gv = ((const GAS f32x4*)ln2g)[lane + 64 * j], bv = ((const GAS f32x4*)ln2b)[lane + 64 * j]; __builtin_nontemporal_store(v[j] * rstd * gv + bv, orow + 64 * j); }
        a0 = a1; a1 = a2; y0 = y1;
    }
}

struct Args { const float* in[23]; float* out; unsigned char* ws; int ph_lo, ph_hi; };
__global__ void __launch_bounds__(NWAVES * 64, 2) mega_fwd(Args args) {
    extern __shared__ __attribute__((aligned(16))) unsigned char lds[];
    Frame F;
    F.lds = (LAS unsigned char*)lds;
    F.MISC = (volatile LAS unsigned*)(F.lds + MISC_OFF);
    F.tid = threadIdx.x; F.lane = F.tid & 63; F.wave = __builtin_amdgcn_readfirstlane(F.tid >> 6);
    F.G = gridDim.x; { const int bx = blockIdx.x; F.vcu = (F.G % 8 == 0) ? (bx % 8) * (F.G / 8) + bx / 8 : bx; }
    unsigned char* ws = args.ws;
    F.ctl = (gu32*)(ws + WS_CTL);
    for (int u = F.tid; u < (LDS_BYTES - LDSCTL_OFF) / 4; u += NWAVES * 64) ((LAS unsigned*)(F.lds + LDSCTL_OFF))[u] = 0u;
    __syncthreads();
    XcdBarrier bar = xcd_barrier_post((unsigned*)(F.ctl + CW_BAR), F.MISC + 8);
    const int lo = args.ph_lo, hi = args.ph_hi;
#define IN(k) (lo <= (k) && (k) < hi)
#define BOTH(k) (IN(k) && IN((k) + 1))

    if (IN(0)) {
        P0Args a{args.in[0], args.in[1], args.in[2], args.in[3], args.in[4], args.in[12], args.in[17], args.in[19], args.in[10], args.in[15]};
        p0_prologue(F, a, ws, (BOTH(0) && F.G == 256) ? P1_LN0 : MP);
        if (BOTH(0)) xcd_barrier(bar);
    }
    if (IN(1)) {
        pg8::Gemm g{(const pg8::bf16_t*)(ws + WS_H0B), (const pg8::bf16_t*)(ws + WS_WIN), MP, DIN, D};
        pg8::StaticOrder S; S.init(MP, DIN, F.G, (int)blockIdx.x);
        pg8::EpiProj E{(pg8::bf16_t*)(ws + WS_QA), (pg8::bf16_t*)(ws + WS_KA), (pg8::bf16_t*)(ws + WS_VA), (pg8::bf16_t*)(ws + WS_QB), (pg8::bf16_t*)(ws + WS_VB), (pg8::bf16_t*)(ws + WS_GB),
                       (float*)(ws + WS_LF), (const float*)(ws + WS_ROPE), (const float*)(ws + WS_LB)};
        if (BOTH(0) && F.G == 256) {
            const int xo = F.vcu & 31, xx = F.vcu >> 5; const bool prod = xo >= 32 - P1_NPX;
            if (prod) { P0Args a{args.in[0], args.in[1], args.in[2], args.in[3], args.in[4], args.in[12], args.in[17], args.in[19], args.in[10], args.in[15]};
                p0_ln_producer(F, a, ws, xx * P1_NPX + (xo - (32 - P1_NPX))); }
            constexpr int NCONS = 8 * (32 - P1_NPX), NPRODW = 8 * P1_NPX, NU = (MP / 256) * (DIN / 256);
            pg8::P1Order S1{prod ? 4 * NCONS + xx * P1_NPX + (xo - (32 - P1_NPX)) : xx * (32 - P1_NPX) + xo, prod ? NPRODW : NCONS, prod ? P1_PU : 4, DIN / 256, NU, P1_LN0 / 256, (unsigned*)(F.ctl + CW_LN), 0ull, 0ull};
            static_assert(4 * NCONS + P1_PU * NPRODW >= NU, "unit deal must cover the input projection");
            pg8::gemm_phase<pg8::EpiProj, pg8::P1Order, true>(F.lds + RING_OFF, g, S1, E);
        } else {
            pg8::gemm_phase<pg8::EpiProj, pg8::StaticOrder, true>(F.lds + RING_OFF, g, S, E);
            if (F.G == 256 && (int)blockIdx.x >= P1_SHORT0) conv_job(F, (int)blockIdx.x - P1_SHORT0, args.in[17], args.in[19], ws);
        }
        if (BOTH(1)) xcd_barrier(bar);
    }
    if (IN(2)) {
        float lam;
        { const float a = wave_sum(args.in[5][F.lane] * args.in[6][F.lane]), c = wave_sum(args.in[7][F.lane] * args.in[8][F.lane]); lam = expf(a) - expf(c) + LAM_INIT; }
        const float* LFp = (const float*)(ws + WS_LF); const bf16* QBp = (const bf16*)(ws + WS_QB); const bf16* VBp = (const bf16*)(ws + WS_VB); const bf16* GBp = (const bf16*)(ws + WS_GB);
        bf16* UHp = (bf16*)(ws + WS_UH); float* ELp = (float*)(ws + WS_EL); bf16* SPp = (bf16*)(ws + WS_SP);
        constexpr int QJOBS = 132 + 64 + 32 + 96 + 132;
        static_assert(CONV_JOBS == 768 && hg::NUNIT == 8 * 132, "queue layout assumes 512 attention units, 768 conversion jobs and 1056 HGRN2 units");
        const int myx = (int)(xb_xcc_id() & 7u);
        int cpar = 0;
        for (int sx = 0; sx < 8; ++sx) {
            const int x = (myx + sx) & 7;
            if (F.tid == 0) F.MISC[0] = __hip_atomic_fetch_add(F.ctl + CW_JOB + 64 * x, 1u, RLX_AGENT);
            __syncthreads();
            int job = __builtin_amdgcn_readfirstlane((int)F.MISC[0]);
            __syncthreads();
            while (job < QJOBS) {
                unsigned nextj = 0u;
                if (F.tid == 0) nextj = __hip_atomic_fetch_add(F.ctl + CW_JOB + 64 * x, 1u, RLX_AGENT);
                int ua = -1, sj = -1, cv = -1, cu = -1, au = -1;
                if (job < 132) ua = job;
                else if (job < 228) { const int k = job - 132, g = k / 3, r = k - g * 3; if (r == 0) au = g; else cv = 2 * g + (r - 1); }
                else if (job < 260) sj = job - 228;
                else if (job < 324) { const int k = job - 260; if (k & 1) cv = 64 + (k >> 1); else au = 32 + (k >> 1); }
                else cu = job - 324;
                if (ua >= 0) { const int u = x * 132 + ua; hg::hgA_unit(F, u, cpar, LFp, VBp, UHp, ELp, F.ctl + CW_HGA + 64 * (u / 33)); cpar ^= 1; }
                else if (sj >= 0) { const int bh = 4 * x + (sj >> 3), wq = sj & 7;
                    hg::hg_wait(F, F.ctl + CW_HGA + 64 * bh, 33u);
                    hg::hg_scan_job((bh << 6) | (wq << 3) | F.wave, F.lane, UHp, ELp, SPp);
                    hg::hg_arrive(F, F.ctl + CW_HGS + 64 * bh); }
                else if (cv >= 0) { const bool p1tail = (F.G == 256) && !BOTH(0);
                    const int cid = p1tail ? CONV_P1 + x * CONV_PER_X + cv : x * 96 + cv; if (!p1tail || (cv < CONV_PER_X && cid < CONV_JOBS)) conv_job(F, cid, args.in[17], args.in[19], ws); }
                else if (cu >= 0) { const int u = x * 132 + cu; hg::hgC_unit(F, u, cpar, QBp, LFp, VBp, GBp, SPp, (bf16*)(ws + WS_Y), args.in[11], F.ctl + CW_HGS + 64 * (u / 33)); cpar ^= 1; }
                else { const int i = 15 - au / 4, bh = 4 * x + (au & 3);
                    att::attn_unit(F, bh >> 2, bh & 3, i, (const bf16*)(ws + WS_QA), (const bf16*)(ws + WS_KA), (const bf16*)(ws + WS_VA), (bf16*)(ws + WS_Y), lam, args.in[9]); }
                __syncthreads();
                if (F.tid == 0) F.MISC[0] = nextj;
                __syncthreads();
                job = __builtin_amdgcn_readfirstlane((int)F.MISC[0]);
                __syncthreads();
            }
        }
        if (BOTH(2)) xcd_barrier(bar);
    }
    if (IN(3)) {
        pg8::Gemm g{(const pg8::bf16_t*)(ws + WS_Y), (const pg8::bf16_t*)(ws + WS_WOUT), MR, D, D};
        pg8::StaticOrderT<true> S; S.init(MR, D, F.G, (int)blockIdx.x);
        pg8::EpiOut E{args.in[0], (const float*)(ws + WS_STATS), args.in[2], args.in[3], (float*)(ws + WS_PRE1)};
        pg8::gemm_phase<pg8::EpiOut, pg8::StaticOrderT<true>, true>(F.lds + RING_OFF, g, S, E);
        if (BOTH(3)) xcd_barrier(bar);
    }
    if (IN(4)) {
        p4_router(F, ws, args.in[13], args.in[14], args.in[16], CW_CNT);
        if (BOTH(4)) xcd_barrier(bar);
    }
    if (IN(5)) {
        moe_tile_prefix(F, ws);
        pg8::Gemm g{(const pg8::bf16_t*)(ws + WS_H1B), (const pg8::bf16_t*)(ws + WS_WGU), 0, 2 * D, FP8_GU ? D / 2 : D};
        pg8::GroupedOrder<true> S{(const LAS int*)(F.lds + TPRE_OFF), (const int*)(ws + WS_CTL) + CW_CNT, (const int*)(ws + WS_LIST), 3, F.G, F.vcu, (size_t)2 * D * D * (FP8_GU ? 1 : 2)};
        pg8::EpiGU<FP8_DN> E{args.in[18], (pg8::bf16_t*)(ws + WS_ACT), FP8_GU ? 1.0f / W_GU_SCALE : 1.0f};
        pg8::gemm_phase<pg8::EpiGU<FP8_DN>, pg8::GroupedOrder<true>, true, FP8_GU>(F.lds + RING_OFF, g, S, E);
        if (BOTH(5)) {
            if (MOE_SPLIT_SEAM && F.G == 256) {
                const int Rr = (8 * ((const LAS int*)(F.lds + TPRE_OFF))[32]) & 255;
                asm volatile("s_waitcnt vmcnt(0)" ::: "memory");
                __syncthreads();
                if (F.tid == 0) { __builtin_amdgcn_fence(__ATOMIC_RELEASE, "agent"); asm volatile("s_waitcnt vmcnt(0)" ::: "memory");
                    __hip_atomic_fetch_add(F.ctl + CW_GRP + (F.vcu < Rr ? 64 : 0), 1u, RLX_AGENT); }
            } else xcd_barrier(bar);
        }
    }
    if (IN(6)) {
        moe_tile_prefix(F, ws);
        pg8::Gemm g{(const pg8::bf16_t*)(ws + WS_ACT), (const pg8::bf16_t*)(ws + WS_WDN), 0, D, FP8_DN ? D / 2 : D};
        pg8::EpiDN<FP8_YE> E{args.in[20], (pg8::bf16_t*)(ws + WS_YE), FP8_DN ? 1.0f / W_DN_SCALE : 1.0f, YE_SCALE};
        if (MOE_SPLIT_SEAM && F.G == 256 && BOTH(5)) {
            const int Rr = (8 * ((const LAS int*)(F.lds + TPRE_OFF))[32]) & 255;
            pg8::SplitOrder S{(const LAS int*)(F.lds + TPRE_OFF), (unsigned*)(ws + WS_CTL) + CW_GRP, F.G, F.vcu, Rr, (size_t)D * D * (FP8_DN ? 1 : 2), 0u};
            pg8::gemm_phase<pg8::EpiDN<FP8_YE>, pg8::SplitOrder, true, FP8_DN>(F.lds + RING_OFF, g, S, E);
        } else {
            pg8::GroupedOrder<false> S{(const LAS int*)(F.lds + TPRE_OFF), (const int*)(ws + WS_CTL) + CW_CNT, nullptr, 2, F.G, F.vcu, (size_t)D * D * (FP8_DN ? 1 : 2)};
            pg8::gemm_phase<pg8::EpiDN<FP8_YE>, pg8::GroupedOrder<false>, true, FP8_DN>(F.lds + RING_OFF, g, S, E);
        }
        if (BOTH(6)) xcd_barrier(bar);
    }
    if (IN(7)) {
        moe_tile_prefix(F, ws);
        p7_final(F, ws, args.in[13], args.in[14], args.in[21], args.in[22], args.out);
    }
#undef IN
#undef BOTH
}


extern "C" void kernel_launch(void* const* d_in, const int* in_sizes, int n_in, void* d_out, int out_size, void* d_ws, size_t ws_size, hipStream_t stream) {
    static int grid = 0;
    if (grid == 0) {
        int dev = 0, cus = 0;
        if (hipGetDevice(&dev) != hipSuccess || hipDeviceGetAttribute(&cus, hipDeviceAttributeMultiprocessorCount, dev) != hipSuccess) { fprintf(stderr, "kernel_launch: device query failed\n"); grid = -1; return; }
        if (hipFuncSetAttribute((const void*)mega_fwd, hipFuncAttributeMaxDynamicSharedMemorySize, LDS_BYTES) != hipSuccess) { fprintf(stderr, "kernel_launch: hipFuncSetAttribute failed\n"); grid = -1; return; }
        int per_cu = 0;
        if (hipOccupancyMaxActiveBlocksPerMultiprocessor(&per_cu, (const void*)mega_fwd, NWAVES * 64, LDS_BYTES) != hipSuccess || per_cu < 1) fprintf(stderr, "kernel_launch: occupancy query reports %d\n", per_cu);
        (void)hipGetLastError();
        grid = cus;
    }
    if (grid < 0) return;
    (void)in_sizes; (void)n_in; (void)out_size; (void)ws_size;
    unsigned char* ws = (unsigned char*)d_ws;
    if (hipMemsetAsync(ws + WS_CTL, 0, CTL_ZERO_BYTES, stream) != hipSuccess) { fprintf(stderr, "kernel_launch: memset failed\n"); return; }
    Args a{};
    for (int i = 0; i < 23; ++i) a.in[i] = (const float*)d_in[i];
    a.out = (float*)d_out; a.ws = ws; a.ph_lo = 0; a.ph_hi = 8;
    hipLaunchKernelGGL(mega_fwd, dim3(grid), dim3(NWAVES * 64), LDS_BYTES, stream, a);

}
```
